# Optimizing an MI355X kernel written in HIP

```python
import jax, jax.numpy as jnp
from jax import lax
import numpy as np

D_MODEL = 4096
BATCH = 4
SEQ = 2048
DEPTH = 2
DEC_BATCH = 8
DEC_SEQ = 16
PAST_LEN = 4096

CHUNK = 64
EPS = 1e-6
NEG_BIG = -1e30
LB_FLOOR = 1e-30
A_HEADS = 8
A_DK = 128
A_DV = 128
A_WIDTH = A_HEADS * A_DV
B_HEADS = 32
B_KV_HEADS = 4
B_GROUP = B_HEADS // B_KV_HEADS
B_HD = 64
B_WIDTH = B_HEADS * B_HD
B_SCALE = B_HD ** -0.5
WINDOW = 128
WINDOW_CHUNKS = WINDOW // CHUNK
ROPE_THETA = 10000.0
C_HEADS = 8
C_DK = 64
C_DV = 128
C_WIDTH = C_HEADS * C_DV
GLA_RANK = 16
GLA_NORMALIZER = 16.0
MIX_WIDTH = A_WIDTH + B_WIDTH + C_WIDTH
D_FF = ((8 * D_MODEL + 3 * 256 - 1) // (3 * 256)) * 256
IN_SPLITS = (A_HEADS * A_DK, A_HEADS * A_DK, A_WIDTH, A_WIDTH,
             B_WIDTH, B_KV_HEADS * B_HD, B_KV_HEADS * B_HD,
             C_HEADS * C_DK, C_HEADS * C_DK, C_WIDTH, C_WIDTH, GLA_RANK)
IN_COLS = sum(IN_SPLITS)

kernel_name = 'hymba_hgrn2_swasink_gla_stream_step'


def rmsnorm(x, g):
    xf = x.astype(jnp.float32)
    y = xf * lax.rsqrt(jnp.mean(xf * xf, axis=-1, keepdims=True) + EPS)
    return (y * g.astype(jnp.float32)).astype(x.dtype)


def rope(x, pos):
    half = x.shape[-1] // 2
    inv = ROPE_THETA ** (-jnp.arange(half, dtype=jnp.float32) / half)
    ang = pos.astype(jnp.float32)[:, None] * inv[None, :]
    cos = jnp.cos(ang)[:, None, :]
    sin = jnp.sin(ang)[:, None, :]
    xf = x.astype(jnp.float32)
    x1, x2 = xf[..., :half], xf[..., half:]
    return jnp.concatenate([x1 * cos - x2 * sin, x2 * cos + x1 * sin], axis=-1).astype(x.dtype)


def split_cols(proj):
    idx, acc = [], 0
    for s in IN_SPLITS[:-1]:
        acc += s
        idx.append(acc)
    return jnp.split(proj, idx, axis=-1)


def gated_linear_recurrence(q, k, v, log_f, s0, block):
    b, t, h, dk = q.shape
    dv = v.shape[-1]
    nb = t // block

    def to_blocks(a):
        return jnp.moveaxis(a.reshape(b, nb, block, h, a.shape[-1]), 1, 0)

    qb, kb, vb, gb = to_blocks(q), to_blocks(k), to_blocks(v), to_blocks(log_f)
    causal = jnp.tril(jnp.ones((block, block), dtype=bool))[None, :, :, None, None]

    def step(s, inp):
        qc, kc, vc, gc = [a.astype(jnp.float32) for a in inp]
        cum = jnp.cumsum(gc, axis=1)
        diff = cum[:, :, None] - cum[:, None, :]
        decay = jnp.where(causal, jnp.exp(jnp.where(causal, diff, 0.0)), 0.0)
        attn = jnp.einsum('bthd,bshd,btshd->bhts', qc, kc, decay)
        o_intra = jnp.einsum('bhts,bshv->bthv', attn, vc)
        o_inter = jnp.einsum('bthd,bhdv->bthv', qc * jnp.exp(cum), s)
        last = cum[:, -1]
        k_dec = kc * jnp.exp(last[:, None] - cum)
        s_new = jnp.exp(last)[..., None] * s + jnp.einsum('bshd,bshv->bhdv', k_dec, vc)
        return s_new, o_intra + o_inter

    s_final, o = lax.scan(step, s0.astype(jnp.float32), (qb, kb, vb, gb))
    o = jnp.moveaxis(o, 0, 1).reshape(b, t, h, dv)
    return o, s_final


def hgrn2_mixer(a_q, a_f, a_i, a_g, lb, norm_g, s0, block):
    b, t, _ = a_q.shape
    z = a_f.astype(jnp.float32)
    log_f = jnp.logaddexp(jnp.log(jnp.maximum(lb, LB_FLOOR)), jnp.log1p(-lb) + jax.nn.log_sigmoid(z))
    k_in = (1.0 - lb) * jax.nn.sigmoid(-z)
    shp = (b, t, A_HEADS, A_DK)
    o, s_new = gated_linear_recurrence(a_q.reshape(shp), k_in.reshape(shp),
                                       a_i.reshape(b, t, A_HEADS, A_DV), log_f.reshape(shp), s0, block)
    o = rmsnorm(o, norm_g) * jax.nn.silu(a_g.astype(jnp.float32)).reshape(b, t, A_HEADS, A_DV)
    return o.reshape(b, t, A_WIDTH).astype(a_q.dtype), s_new


def gla_mixer(c_q, c_k, c_v, c_r, c_a, w_a2, b_a, norm_g, s0, block):
    b, t, _ = c_q.shape
    log_alpha = jax.nn.log_sigmoid((c_a @ w_a2 + b_a).astype(jnp.float32)) / GLA_NORMALIZER
    shp = (b, t, C_HEADS, C_DK)
    o, s_new = gated_linear_recurrence(c_q.reshape(shp) * (C_DK ** -0.5), c_k.reshape(shp),
                                       c_v.reshape(b, t, C_HEADS, C_DV), log_alpha.reshape(shp), s0, block)
    o = rmsnorm(o, norm_g) * jax.nn.silu(c_r.astype(jnp.float32)).reshape(b, t, C_HEADS, C_DV)
    return o.reshape(b, t, C_WIDTH).astype(c_q.dtype), s_new


def sink_softmax(scores, sinks):
    sink = jnp.broadcast_to(sinks.astype(jnp.float32).reshape(B_KV_HEADS, B_GROUP, 1, 1),
                            scores.shape[:-1] + (1,))
    return jax.nn.softmax(jnp.concatenate([scores, sink], axis=-1), axis=-1)[..., :-1]


def swa_prompt(q, k, v, sinks):
    b, t = q.shape[:2]
    nc = t // CHUNK
    band = (WINDOW_CHUNKS + 1) * CHUNK
    qc = q.reshape(b, nc, CHUNK, B_KV_HEADS, B_GROUP, B_HD)

    def banded(a):
        ap = jnp.pad(a, ((0, 0), (WINDOW_CHUNKS * CHUNK, 0), (0, 0), (0, 0)))
        ap = ap.reshape(b, nc + WINDOW_CHUNKS, CHUNK, B_KV_HEADS, B_HD)
        return jnp.concatenate([ap[:, j:j + nc] for j in range(WINDOW_CHUNKS + 1)], axis=2)

    kb, vb = banded(k), banded(v)
    valid = (jnp.arange(nc)[:, None] + jnp.arange(band)[None, :] // CHUNK) >= WINDOW_CHUNKS
    scores = jnp.einsum('bcqkgd,bcskd->bckgqs', qc, kb).astype(jnp.float32) * B_SCALE
    scores = jnp.where(valid[None, :, None, None, None, :], scores, NEG_BIG)
    p = sink_softmax(scores, sinks).astype(v.dtype)
    o = jnp.einsum('bckgqs,bcskd->bcqkgd', p, vb)
    return o.reshape(b, t, B_WIDTH)


def swa_sample(q, k, v, cache_k, cache_v, sinks):
    b, t = q.shape[:2]
    qs = q.reshape(b, t, B_KV_HEADS, B_GROUP, B_HD)
    ka = jnp.concatenate([cache_k.astype(k.dtype), k], axis=1)
    va = jnp.concatenate([cache_v.astype(v.dtype), v], axis=1)
    scores = jnp.einsum('bqkgd,bskd->bkgqs', qs, ka).astype(jnp.float32) * B_SCALE
    p = sink_softmax(scores, sinks).astype(v.dtype)
    o = jnp.einsum('bkgqs,bskd->bqkgd', p, va)
    return o.reshape(b, t, B_WIDTH)


def hybrid_layer(x, pos, block, kv_cache, s_a, s_c, lb, norm_mix, w_in, hgrn_norm, sinks,
                 w_a2, b_a, gla_norm, w_out, norm_ffn, w_gate_up, w_down):
    b, t, _ = x.shape
    h = rmsnorm(x, norm_mix)
    a_q, a_f, a_i, a_g, b_q, b_k, b_v, c_q, c_k, c_v, c_r, c_a = split_cols(h @ w_in)
    o_a, s_a_new = hgrn2_mixer(a_q, a_f, a_i, a_g, lb, hgrn_norm, s_a, block)
    q = rope(b_q.reshape(b, t, B_HEADS, B_HD), pos)
    k = rope(b_k.reshape(b, t, B_KV_HEADS, B_HD), pos)
    v = b_v.reshape(b, t, B_KV_HEADS, B_HD)
    if kv_cache is None:
        o_b = swa_prompt(q, k, v, sinks)
        k_rows, v_rows = k[:, -WINDOW:], v[:, -WINDOW:]
    else:
        o_b = swa_sample(q, k, v, kv_cache[0], kv_cache[1], sinks)
        k_rows, v_rows = k, v
    o_c, s_c_new = gla_mixer(c_q, c_k, c_v, c_r, c_a, w_a2, b_a, gla_norm, s_c, block)
    x = x + jnp.concatenate([o_a, o_b, o_c], axis=-1) @ w_out
    h = rmsnorm(x, norm_ffn)
    gate, up = jnp.split(h @ w_gate_up, 2, axis=-1)
    x = x + (jax.nn.silu(gate) * up) @ w_down
    return x, k_rows, v_rows, s_a_new, s_c_new


def setup_inputs(seed: int = 0) -> dict:
    key = jax.random.key(seed)
    ks = jax.random.split(key, 20)
    f32 = jnp.float32

    def nrm(k, shape, scale):
        return jax.random.normal(k, shape, dtype=f32) * scale

    cache_rows = min(WINDOW, PAST_LEN)
    return {
        'x_prompt': nrm(ks[0], (BATCH, SEQ, D_MODEL), 1.0),
        'x_sample': nrm(ks[1], (DEC_BATCH, DEC_SEQ, D_MODEL), 1.0),
        'cache_k_swa': nrm(ks[2], (DEPTH, DEC_BATCH, cache_rows, B_KV_HEADS, B_HD), 1.0),
        'cache_v_swa': nrm(ks[3], (DEPTH, DEC_BATCH, cache_rows, B_KV_HEADS, B_HD), 1.0),
        'state_hgrn': nrm(ks[4], (DEPTH, DEC_BATCH, A_HEADS, A_DK, A_DV), 0.5),
        'state_gla': nrm(ks[5], (DEPTH, DEC_BATCH, C_HEADS, C_DK, C_DV), 0.5),
        'norm_mix': 1.0 + nrm(ks[6], (DEPTH, D_MODEL), 0.02),
        'w_in': nrm(ks[7], (DEPTH, D_MODEL, IN_COLS), D_MODEL ** -0.5),
        'hgrn_lb_logits': nrm(ks[8], (DEPTH, A_HEADS * A_DK), 0.5),
        'hgrn_norm': 1.0 + nrm(ks[9], (DEPTH, A_DV), 0.02),
        'swa_sinks': nrm(ks[10], (DEPTH, B_HEADS), 0.5),
        'gla_w_alpha2': nrm(ks[11], (DEPTH, GLA_RANK, C_HEADS * C_DK), GLA_RANK ** -0.5),
        'gla_b_alpha': nrm(ks[12], (DEPTH, C_HEADS * C_DK), 0.1),
        'gla_norm': 1.0 + nrm(ks[13], (DEPTH, C_DV), 0.02),
        'w_out': nrm(ks[14], (DEPTH, MIX_WIDTH, D_MODEL), MIX_WIDTH ** -0.5),
        'norm_ffn': 1.0 + nrm(ks[15], (DEPTH, D_MODEL), 0.02),
        'w_gate_up': nrm(ks[16], (DEPTH, D_MODEL, 2 * D_FF), D_MODEL ** -0.5),
        'w_down': nrm(ks[17], (DEPTH, D_FF, D_MODEL), D_FF ** -0.5),
        'norm_final': 1.0 + nrm(ks[18], (D_MODEL,), 0.02),
    }


def reference(x_prompt, x_sample, cache_k_swa, cache_v_swa, state_hgrn, state_gla,
              norm_mix, w_in, hgrn_lb_logits, hgrn_norm, swa_sinks, gla_w_alpha2, gla_b_alpha,
              gla_norm, w_out, norm_ffn, w_gate_up, w_down, norm_final):
    probs = jax.nn.softmax(hgrn_lb_logits.astype(jnp.float32), axis=0)
    lower_bounds = jnp.cumsum(probs, axis=0) - probs[0:1]

    n_p, t_p = x_prompt.shape[0], x_prompt.shape[1]
    n_s, t_s = x_sample.shape[0], x_sample.shape[1]
    pos_p = jnp.arange(t_p)
    pos_s = PAST_LEN + jnp.arange(t_s)
    zeros_a = jnp.zeros((n_p, A_HEADS, A_DK, A_DV), jnp.float32)
    zeros_c = jnp.zeros((n_p, C_HEADS, C_DK, C_DV), jnp.float32)

    xp, xs = x_prompt, x_sample
    kp_l, vp_l, sap_l, scp_l = [], [], [], []
    ks_l, vs_l, sas_l, scs_l = [], [], [], []
    for l in range(DEPTH):
        w = (lower_bounds[l], norm_mix[l], w_in[l], hgrn_norm[l], swa_sinks[l],
             gla_w_alpha2[l], gla_b_alpha[l], gla_norm[l], w_out[l], norm_ffn[l], w_gate_up[l], w_down[l])
        xp, kr, vr, sa, sc = hybrid_layer(xp, pos_p, CHUNK, None, zeros_a, zeros_c, *w)
        kp_l.append(kr); vp_l.append(vr); sap_l.append(sa); scp_l.append(sc)
        xs, kr, vr, sa, sc = hybrid_layer(xs, pos_s, t_s, (cache_k_swa[l], cache_v_swa[l]),
                                          state_hgrn[l], state_gla[l], *w)
        ks_l.append(kr); vs_l.append(vr); sas_l.append(sa); scs_l.append(sc)

    y_prompt = rmsnorm(xp, norm_final)
    y_sample = rmsnorm(xs, norm_final)
    return (y_prompt, y_sample,
            jnp.stack(kp_l), jnp.stack(vp_l), jnp.stack(sap_l), jnp.stack(scp_l),
            jnp.stack(ks_l), jnp.stack(vs_l), jnp.stack(sas_l), jnp.stack(scs_l))
```

```cpp
#include <hip/hip_runtime.h>
#include <cstdio>
#include <cstdint>
namespace pg8 {
#define PG8_LAS __attribute__((address_space(3)))
typedef unsigned short bf16_t;
typedef short bf16x8 __attribute__((ext_vector_type(8)));
typedef float f32x4 __attribute__((ext_vector_type(4)));
typedef unsigned u32x4 __attribute__((ext_vector_type(4)));
constexpr int BM = 256, BK = 64, HALF = 128, HTB = HALF * BK * 2  , STAGE_BYTES = 8 * HTB, NXCD = 8;

__host__ __device__ __forceinline__ int lds_byte(int r, int c) { const int st = (r >> 4) * 2 + (c >> 5), rr = r & 15, cc = c & 31, ob = rr * 64 + cc * 2; return st * 1024 + (ob ^ (((ob >> 9) & 1) << 5)); }
__host__ __device__ __forceinline__ void stage_rc(int b, int& R, int& C) { const int st = b / 1024, sb = b % 1024, swz = sb ^ (((sb >> 9) & 1) << 5); R = (st >> 1) * 16 + swz / 64; C = (st & 1) * 32 + (swz % 64) / 2; }
__host__ __device__ __forceinline__ int perm32(int rho) { const int n = rho >> 4, i = rho & 15; return 8 * (i >> 2) + 4 * n + (i & 3); }

struct Unit { int pm, pn, kb, nt, ch, brow; };
struct Gemm { const bf16_t* A; const bf16_t* Bt; int M, N, K; };

struct StaticOrder {
    int nM, nN, nwg, G, c, ntk, WGM = 8;
    __host__ __device__ void init(int M, int N, int K, int G_, int c_) { nM = M / BM; nN = N / BM; nwg = nM * nN; G = G_; c = c_; ntk = K / BK; }
    __host__ __device__ bool next(int i, Unit& u) const {
        const long L = (long)i * G + c; if (L >= nwg) return false;
        int wgid = (int)L; { const int q = nwg / NXCD, r = nwg % NXCD, xcd = wgid % NXCD, off = wgid / NXCD; wgid = (xcd < r ? xcd * (q + 1) : r * (q + 1) + (xcd - r) * q) + off; }
        const int nig = WGM * nN, gid = wgid / nig, fm = gid * WGM, gsz = (nM - fm) < WGM ? (nM - fm) : WGM;
        u.pm = fm + ((wgid % nig) % gsz); u.pn = (wgid % nig) / gsz; u.kb = 0; u.nt = ntk; u.ch = 0; u.brow = 2 * u.pn; return true;
    }
    __device__ __forceinline__ void a_ready(const Unit&) const {}
    __device__ __forceinline__ void done(const Unit&) const {}
};
struct PanelOrder {
    int pm, nN, nchunk, ntk, first, stride, count;
    __host__ __device__ bool next(int i, Unit& u) const {
        if (first < 0) return false; const int j = first + i * stride; if (j >= count) return false;
        u.pm = pm; u.pn = j % nN; const int ch = j / nN, pairs = ntk / 2, p0 = pairs * ch / nchunk, p1 = pairs * (ch + 1) / nchunk; u.kb = 2 * p0; u.nt = 2 * (p1 - p0); u.ch = ch; u.brow = 2 * u.pn; return true;
    }
    __device__ __forceinline__ void a_ready(const Unit&) const {}
    __device__ __forceinline__ void done(const Unit&) const {}
};
struct TriOrder {
    int pm, nhalf, ntk, first, stride;
    __host__ __device__ bool next(int i, Unit& u) const {
        const int count = (nhalf + 2) / 3; if (first < 0) return false; const int j = first + i * stride; if (j >= count) return false;
        u.pm = pm; u.pn = j; u.kb = 0; u.nt = ntk; u.ch = 0; u.brow = (3 * j + 3 <= nhalf) ? 3 * j : nhalf - 3; return true;
    }
    __device__ __forceinline__ void a_ready(const Unit&) const {}
    __device__ __forceinline__ void done(const Unit&) const {}
};

__device__ __forceinline__ unsigned cvt_pk_bf16(float lo, float hi) { unsigned r; asm volatile("v_cvt_pk_bf16_f32 %0, %1, %2" : "=v"(r) : "v"(lo), "v"(hi)); return r; }
__device__ __forceinline__ float silu_f(float g) { return g * __builtin_amdgcn_rcpf(1.0f + __expf(-g)); }
__device__ __forceinline__ float rstd_of(float ss) { return __builtin_amdgcn_rsqf(ss * (1.0f / 4096.0f) + 1e-6f); }
template <int NAI> struct EpiProj {
    static constexpr bool PERM = true, AFTER_DRAIN = false;
    bf16_t* O; int ldc; const float* ss;
    __device__ __forceinline__ void operator()(const f32x4 (&acc)[2][2][4][2], const Unit& u, int wr, int wc, int fr, int fq) const {
        const int row0 = u.pm * BM + wr * 64 + fr, col0 = u.pn * BM + wc * 32 + 8 * fq;
        float rs[NAI][4];
#pragma unroll
        for (int ai = 0; ai < NAI; ++ai)
#pragma unroll
            for (int m = 0; m < 4; ++m) rs[ai][m] = rstd_of(ss[row0 + ai * HALF + m * 16]);
#pragma unroll
        for (int ai = 0; ai < NAI; ++ai)
#pragma unroll
            for (int m = 0; m < 4; ++m) { bf16_t* rowp = O + (size_t)(row0 + ai * HALF + m * 16) * ldc + col0; const float r = rs[ai][m];
#pragma unroll
                for (int bj = 0; bj < 2; ++bj) { const f32x4 v0 = acc[ai][bj][m][0] * r, v1 = acc[ai][bj][m][1] * r;
                    u32x4 w; w.x = cvt_pk_bf16(v0[0], v0[1]); w.y = cvt_pk_bf16(v0[2], v0[3]); w.z = cvt_pk_bf16(v1[0], v1[1]); w.w = cvt_pk_bf16(v1[2], v1[3]);
                    *(u32x4*)(rowp + bj * HALF) = w; } }
    }
};
template <int NAI> struct EpiSwiGLU {
    static constexpr bool PERM = true, AFTER_DRAIN = false;
    bf16_t* O; int ldc; const float* ss;
    __device__ __forceinline__ void operator()(const f32x4 (&acc)[2][2][4][2], const Unit& u, int wr, int wc, int fr, int fq) const {
        const int row0 = u.pm * BM + wr * 64 + fr, col0 = u.pn * HALF + wc * 32 + 8 * fq;
        float rs[NAI][4];
#pragma unroll
        for (int ai = 0; ai < NAI; ++ai)
#pragma unroll
            for (int m = 0; m < 4; ++m) rs[ai][m] = rstd_of(ss[row0 + ai * HALF + m * 16]);
#pragma unroll
        for (int ai = 0; ai < NAI; ++ai)
#pragma unroll
            for (int m = 0; m < 4; ++m) { bf16_t* rowp = O + (size_t)(row0 + ai * HALF + m * 16) * ldc + col0; const float r = rs[ai][m];
                const f32x4 g0 = acc[ai][0][m][0] * r, g1 = acc[ai][0][m][1] * r, u0 = acc[ai][1][m][0] * r, u1 = acc[ai][1][m][1] * r;
                u32x4 w; w.x = cvt_pk_bf16(silu_f(g0[0]) * u0[0], silu_f(g0[1]) * u0[1]); w.y = cvt_pk_bf16(silu_f(g0[2]) * u0[2], silu_f(g0[3]) * u0[3]);
                w.z = cvt_pk_bf16(silu_f(g1[0]) * u1[0], silu_f(g1[1]) * u1[1]); w.w = cvt_pk_bf16(silu_f(g1[2]) * u1[2], silu_f(g1[3]) * u1[3]);
                *(u32x4*)rowp = w; }
    }
};
struct EpiResidN {
    static constexpr bool PERM = true, AFTER_DRAIN = false;
    bf16_t* XB; float* ssp; int ldc;
    __device__ __forceinline__ void operator()(const f32x4 (&acc)[2][2][4][2], const Unit& u, int wr, int wc, int fr, int fq) const {
        const int row0 = u.pm * BM + wr * 64 + fr, col0 = u.pn * BM + wc * 32 + 8 * fq;
        u32x4 xr[2][4][2];
#pragma unroll
        for (int ai = 0; ai < 2; ++ai)
#pragma unroll
            for (int m = 0; m < 4; ++m)
#pragma unroll
                for (int bj = 0; bj < 2; ++bj) xr[ai][m][bj] = *(const u32x4*)(XB + (size_t)(row0 + ai * HALF + m * 16) * ldc + col0 + bj * HALF);
#pragma unroll
        for (int ai = 0; ai < 2; ++ai)
#pragma unroll
            for (int m = 0; m < 4; ++m) { const int row = row0 + ai * HALF + m * 16; bf16_t* bp = XB + (size_t)row * ldc + col0; float s = 0.f;
#pragma unroll
                for (int bj = 0; bj < 2; ++bj) { const u32x4 r = xr[ai][m][bj]; const unsigned rw[4] = {r.x, r.y, r.z, r.w}; float v[8];
#pragma unroll
                    for (int j = 0; j < 4; ++j) { v[2 * j] = __builtin_bit_cast(float, rw[j] << 16) + acc[ai][bj][m][j >> 1][(2 * j) & 3]; v[2 * j + 1] = __builtin_bit_cast(float, rw[j] & 0xffff0000u) + acc[ai][bj][m][j >> 1][(2 * j + 1) & 3]; }
#pragma unroll
                    for (int j = 0; j < 8; ++j) s += v[j] * v[j];
                    u32x4 w; w.x = cvt_pk_bf16(v[0], v[1]); w.y = cvt_pk_bf16(v[2], v[3]); w.z = cvt_pk_bf16(v[4], v[5]); w.w = cvt_pk_bf16(v[6], v[7]);
                    *(u32x4*)(bp + bj * HALF) = w; }
                s += __shfl_xor(s, 16); s += __shfl_xor(s, 32);
                if (fq == 0) ssp[(size_t)row * 64 + u.pn * 4 + wc] = s; }
    }
};
struct EpiPartial {
    static constexpr bool PERM = true, AFTER_DRAIN = false;
    float* P; int ldc;
    __device__ __forceinline__ void operator()(const f32x4 (&acc)[2][2][4][2], const Unit& u, int wr, int wc, int fr, int fq) const {
        const int row0 = wr * 64 + fr, col0 = u.pn * BM + wc * 32 + 8 * fq;
#pragma unroll
        for (int m = 0; m < 4; ++m) { float* rowp = P + ((size_t)u.ch * HALF + row0 + m * 16) * ldc + col0;
#pragma unroll
            for (int bj = 0; bj < 2; ++bj)
#pragma unroll
                for (int n = 0; n < 2; ++n) *(f32x4*)(rowp + bj * HALF + n * 4) = acc[0][bj][m][n]; }
    }
};
struct EpiGU {
    static constexpr bool PERM = true, AFTER_DRAIN = false;
    float* GU; int ldc; const float* ss;
    __device__ __forceinline__ void operator()(const f32x4 (&acc)[2][2][4][2], const Unit& u, int wr, int wc, int fr, int fq) const {
        const int row0 = wr * 64 + fr, col0 = u.brow * HALF + wc * 32 + 8 * fq;
#pragma unroll
        for (int m = 0; m < 4; ++m) { const int row = row0 + m * 16; const float r = rstd_of(ss[row]); float* rowp = GU + (size_t)row * ldc + col0;
#pragma unroll
            for (int n = 0; n < 2; ++n) { *(f32x4*)(rowp + n * 4) = acc[0][0][m][n] * r; *(f32x4*)(rowp + HALF + n * 4) = acc[0][1][m][n] * r; *(f32x4*)(rowp + 2 * HALF + n * 4) = acc[1][0][m][n] * r; } }
    }
};

template <class Epi, class Sched, bool ALIGN_EPI = false, bool SP2 = false, int MODE = 0>
__device__ __forceinline__ void gemm_phase(PG8_LAS unsigned char* lds, const Gemm g, const Sched& S, const Epi& E) {
    int tid_l = threadIdx.x; asm volatile("" : "+v"(tid_l));
    const int tid = tid_l, wid = __builtin_amdgcn_readfirstlane(tid >> 6), lane = tid & 63, wr = wid >> 2, wc = wid & 3, fr = lane & 15, fq = lane >> 4;
    const int K = g.K; constexpr bool HALF_M = MODE != 0; (void)HALF_M; static_assert(MODE != 2 || SP2, "tri units need the SP2 loop");
    unsigned voffA[2], voffB[2];
#pragma unroll
    for (int i = 0; i < 2; ++i) { int R, C; stage_rc(tid * 16 + i * 8192, R, C); const int Rb = Epi::PERM ? ((R & ~31) + perm32(R & 31)) : R;
        voffA[i] = (unsigned)(R * K + C) * 2u; voffB[i] = (unsigned)(Rb * BK + C) * 2u; }
    const size_t kstep = (size_t)(BK * 2);
    const size_t kstepB = (size_t)HTB;
    const size_t hstep = (size_t)HALF * K * 2;
    const size_t tstep = 2 * hstep;
    const unsigned ldsu = (unsigned)(__UINTPTR_TYPE__)lds;
    const unsigned ldsw = (unsigned)wid * 1024u;
    const int aoff = lds_byte(wr * 64 + fr, fq * 8), boff = lds_byte(wc * 32 + fr, fq * 8);
    int boffB_l = boff + 4 * HTB; asm volatile("" : "+v"(boffB_l)); const int boffB = boffB_l;
#define PG8_SA(b, h) (((b) * 2 + (h)) * HTB)
#define PG8_SB(b, h) ((4 + (b) * 2 + (h)) * HTB)
#define PG8_STAGE(bufoff, gbase, voff) do { _Pragma("unroll") for (int _i = 0; _i < 2; ++_i) \
        asm volatile("s_mov_b32 m0, %2\n\ts_nop 0\n\tglobal_load_lds_dwordx4 %0, %1" ::"v"((voff)[_i]), "s"((const char*)(gbase)), "s"(ldsu + (unsigned)(bufoff) + ldsw + (unsigned)(_i * 8192)) : "memory"); } while (0)
#define PG8_LDA(dst, b, h) do { _Pragma("unroll") for (int m = 0; m < 4; ++m) _Pragma("unroll") for (int k = 0; k < 2; ++k) dst[m][k] = *(const PG8_LAS bf16x8*)(lds + PG8_SA(b, h) + aoff + m * 2048 + k * 1024); } while (0)
#define PG8_LDB(dst, b, h) do { _Pragma("unroll") for (int n = 0; n < 2; ++n) _Pragma("unroll") for (int k = 0; k < 2; ++k) dst[n][k] = *(const PG8_LAS bf16x8*)(lds + boffB + ((b) * 2 + (h)) * HTB + n * 2048 + k * 1024); } while (0)
#define PG8_MMA0(ai, bj, At, Bt) do { _Pragma("unroll") for (int m = 0; m < 4; ++m) _Pragma("unroll") for (int n = 0; n < 2; ++n) _Pragma("unroll") for (int k = 0; k < 2; ++k) \
        acc[ai][bj][m][n] = __builtin_amdgcn_mfma_f32_16x16x32_bf16(Bt[n][k], At[m][k], acc[ai][bj][m][n], 0, 0, 0); } while (0)
#define PG8_MMA(ai, bj, At, Bt) do { __builtin_amdgcn_s_setprio(1); PG8_MMA0(ai, bj, At, Bt); __builtin_amdgcn_s_setprio(0); } while (0)
#define PG8_PRIO1 ((void)0)
#define PG8_PRIO0 ((void)0)
#define PG8_WAIT_L0B __builtin_amdgcn_s_waitcnt(0xC07F)
#define PG8_WAIT_VL __builtin_amdgcn_s_waitcnt(0x0078)
#define PG8_STAGE_A1(bufoff, aptr, bptr) do { if constexpr (MODE == 2) PG8_STAGE(bufoff, (bptr) + 2 * hstep, voffB); else PG8_STAGE(bufoff, (aptr) + hstep, voffA); } while (0)
#define PG8_LDB2(dst, b) do { _Pragma("unroll") for (int n = 0; n < 2; ++n) _Pragma("unroll") for (int k = 0; k < 2; ++k) dst[n][k] = *(const PG8_LAS bf16x8*)(lds + PG8_SA(b, 1) + boff + n * 2048 + k * 1024); } while (0)
#define PG8_WAIT_V(n) asm volatile("s_waitcnt vmcnt(" #n ")" ::: "memory")
#define PG8_WAIT_L(n) asm volatile("s_waitcnt lgkmcnt(" #n ")" ::: "memory")
#define PG8_BAR __builtin_amdgcn_s_barrier()
#define PG8_SCHED __builtin_amdgcn_sched_barrier(0)
    Unit cur, nxt; int ui = 0;
    if (!S.next(0, cur)) return;
    f32x4 acc[2][2][4][2];
#pragma unroll
    for (int a = 0; a < 2; ++a)
#pragma unroll
        for (int b = 0; b < 2; ++b)
#pragma unroll
            for (int m = 0; m < 4; ++m)
#pragma unroll
                for (int n = 0; n < 2; ++n) acc[a][b][m][n] = (f32x4){0.f, 0.f, 0.f, 0.f};
    bf16x8 At[4][2], B0[2][2], B1[2][2];
    const char* cA = (const char*)g.A + (size_t)cur.pm * tstep + (size_t)cur.kb * kstep; const char* cB = (const char*)g.Bt + (size_t)cur.brow * hstep + (size_t)cur.kb * kstepB;
    S.a_ready(cur);
    if constexpr (SP2) {
        PG8_STAGE(PG8_SB(0, 0), cB, voffB); PG8_STAGE(PG8_SB(0, 1), cB + hstep, voffB); PG8_STAGE(PG8_SA(0, 0), cA, voffA); PG8_STAGE_A1(PG8_SA(0, 1), cA, cB);
        if (wr == 1) PG8_BAR;
        PG8_WAIT_V(2); PG8_BAR;
        PG8_STAGE(PG8_SB(1, 0), cB + kstepB, voffB); PG8_STAGE(PG8_SA(1, 0), cA + kstep, voffA); PG8_STAGE(PG8_SB(1, 1), cB + hstep + kstepB, voffB);
        PG8_WAIT_V(6); PG8_BAR;
    } else {
        PG8_STAGE(PG8_SB(0, 0), cB, voffB); PG8_STAGE(PG8_SA(0, 0), cA, voffA); PG8_STAGE(PG8_SB(0, 1), cB + hstep, voffB); PG8_STAGE(PG8_SA(0, 1), cA + hstep, voffA);
        if (wr == 1) PG8_BAR;
        PG8_WAIT_V(4); PG8_BAR;
        PG8_STAGE(PG8_SB(1, 0), cB + kstepB, voffB); PG8_STAGE(PG8_SA(1, 0), cA + kstep, voffA); PG8_STAGE(PG8_SB(1, 1), cB + hstep + kstepB, voffB);
        PG8_WAIT_V(6); PG8_BAR;
    }
    for (;;) {
        const bool has_next = S.next(ui + 1, nxt);
        const char* nA = has_next ? (const char*)g.A + (size_t)nxt.pm * tstep + (size_t)nxt.kb * kstep : cA; const char* nB = has_next ? (const char*)g.Bt + (size_t)nxt.brow * hstep + (size_t)nxt.kb * kstepB : cB;
        const int nt = cur.nt;
        for (int t = 0; t < nt; t += 2) {
            const bool last = (t == nt - 2);
            const char* a1 = cA + (size_t)(t + 1) * kstep;
            const char* a2 = last ? nA : cA + (size_t)(t + 2) * kstep; const char* b2 = last ? nB : cB + (size_t)(t + 2) * kstepB;
            const char* a3 = a2 + kstep; const char* b3 = b2 + kstepB;
            if (last && has_next) S.a_ready(nxt);
            if constexpr (SP2) {
            PG8_LDB(B0, 0, 0); PG8_LDB(B1, 0, 1); PG8_SCHED; PG8_LDA(At, 0, 0); PG8_STAGE_A1(PG8_SA(1, 1), a1, cB + (size_t)(t + 1) * kstepB);
            PG8_WAIT_VL; PG8_PRIO1; PG8_BAR; PG8_SCHED; PG8_MMA0(0, 0, At, B0); PG8_MMA0(0, 1, At, B1); PG8_SCHED; PG8_BAR; PG8_PRIO0; PG8_SCHED;
            if constexpr (MODE == 0) PG8_LDA(At, 0, 1); if constexpr (MODE == 2) PG8_LDB2(B0, 0); PG8_STAGE(PG8_SB(0, 0), b2, voffB); PG8_STAGE(PG8_SB(0, 1), b2 + hstep, voffB); PG8_STAGE(PG8_SA(0, 0), a2, voffA);
            PG8_WAIT_VL; PG8_PRIO1; PG8_BAR; PG8_SCHED; if constexpr (MODE == 0) { PG8_MMA0(1, 0, At, B0); PG8_MMA0(1, 1, At, B1); } if constexpr (MODE == 2) { PG8_MMA0(1, 0, At, B0); } PG8_SCHED; PG8_BAR; PG8_PRIO0; PG8_SCHED;
            PG8_LDB(B0, 1, 0); PG8_LDB(B1, 1, 1); PG8_SCHED; PG8_LDA(At, 1, 0); PG8_STAGE_A1(PG8_SA(0, 1), a2, b2);
            PG8_WAIT_VL; PG8_PRIO1; PG8_BAR; PG8_SCHED; PG8_MMA0(0, 0, At, B0); PG8_MMA0(0, 1, At, B1); PG8_SCHED; PG8_BAR; PG8_PRIO0; PG8_SCHED;
            if constexpr (MODE == 0) PG8_LDA(At, 1, 1); if constexpr (MODE == 2) PG8_LDB2(B0, 1); PG8_STAGE(PG8_SB(1, 0), b3, voffB); PG8_STAGE(PG8_SB(1, 1), b3 + hstep, voffB); PG8_STAGE(PG8_SA(1, 0), a3, voffA);
            PG8_WAIT_VL; PG8_PRIO1; PG8_BAR; PG8_SCHED; if constexpr (MODE == 0) { PG8_MMA0(1, 0, At, B0); PG8_MMA0(1, 1, At, B1); } if constexpr (MODE == 2) { PG8_MMA0(1, 0, At, B0); } PG8_SCHED; PG8_BAR; PG8_PRIO0; PG8_SCHED;
            } else {
            PG8_LDB(B0, 0, 0); PG8_SCHED; PG8_LDA(At, 0, 0); PG8_STAGE(PG8_SA(1, 1), a1 + hstep, voffA);
            PG8_WAIT_L(8); PG8_BAR; PG8_WAIT_L(0); PG8_MMA(0, 0, At, B0); PG8_BAR; PG8_SCHED;
            PG8_LDB(B1, 0, 1); PG8_STAGE(PG8_SB(0, 0), b2, voffB);
            PG8_BAR; PG8_WAIT_L(0); PG8_MMA(0, 1, At, B1); PG8_BAR;
            PG8_LDA(At, 0, 1); PG8_STAGE(PG8_SA(0, 0), a2, voffA);
            PG8_BAR; PG8_WAIT_L(0); PG8_MMA(1, 0, At, B0); PG8_BAR; PG8_SCHED;
            PG8_STAGE(PG8_SB(0, 1), b2 + hstep, voffB);
            PG8_WAIT_V(6); PG8_BAR; PG8_MMA(1, 1, At, B1); PG8_BAR;
            PG8_LDB(B0, 1, 0); PG8_SCHED; PG8_LDA(At, 1, 0); PG8_STAGE(PG8_SA(0, 1), a2 + hstep, voffA);
            PG8_WAIT_L(8); PG8_BAR; PG8_WAIT_L(0); PG8_MMA(0, 0, At, B0); PG8_BAR; PG8_SCHED;
            PG8_LDB(B1, 1, 1); PG8_STAGE(PG8_SB(1, 0), b3, voffB);
            PG8_BAR; PG8_WAIT_L(0); PG8_MMA(0, 1, At, B1); PG8_BAR;
            PG8_LDA(At, 1, 1); PG8_STAGE(PG8_SA(1, 0), a3, voffA);
            PG8_BAR; PG8_WAIT_L(0); PG8_MMA(1, 0, At, B0); PG8_BAR; PG8_SCHED;
            PG8_STAGE(PG8_SB(1, 1), b3 + hstep, voffB);
            PG8_WAIT_V(6); PG8_BAR; PG8_MMA(1, 1, At, B1); PG8_BAR;
            }
        }
        if constexpr (ALIGN_EPI) { if (wr == 0) PG8_BAR; }
        if constexpr (!Epi::AFTER_DRAIN) { E(acc, cur, wr, wc, fr, fq); S.done(cur); }
        if (!has_next) break;
#pragma unroll
        for (int a = 0; a < 2; ++a)
#pragma unroll
            for (int b = 0; b < 2; ++b)
#pragma unroll
                for (int m = 0; m < 4; ++m)
#pragma unroll
                    for (int n = 0; n < 2; ++n) acc[a][b][m][n] = (f32x4){0.f, 0.f, 0.f, 0.f};
        cur = nxt; cA = nA; cB = nB; ++ui;
        if constexpr (ALIGN_EPI) { if (wr == 1) PG8_BAR; }
    }
    PG8_WAIT_V(0);
    if constexpr (!ALIGN_EPI) { if (wr == 0) PG8_BAR; }
    PG8_BAR;
    if constexpr (Epi::AFTER_DRAIN) { E.fused(acc, cur, wr, wc, fr, fq, lds, wid, lane); S.done(cur); }
#undef PG8_SA
#undef PG8_SB
#undef PG8_STAGE
#undef PG8_LDA
#undef PG8_LDB
#undef PG8_MMA
#undef PG8_MMA0
#undef PG8_PRIO1
#undef PG8_PRIO0
#undef PG8_WAIT_L0B
#undef PG8_WAIT_VL
#undef PG8_STAGE_A1
#undef PG8_LDB2
#undef PG8_WAIT_V
#undef PG8_WAIT_L
#undef PG8_BAR
#undef PG8_SCHED
}
}

constexpr int D = 4096, NB = 4, TT = 2048, DEPTH = 2, SB = 8, STT = 16;
constexpr int MP = NB * TT;
constexpr int MS = SB * STT;
constexpr int MV = MP + MS;
constexpr int MPAD = 8448;
constexpr int INC = 9744, INP = 9984, DFF = 11008;
constexpr int A_Q = 0, A_F = 1024, A_I = 2048, A_G = 3072, B_Q = 4096, B_K = 6144, B_V = 6400, C_Q = 6656, C_K = 7168, C_V = 7680, C_R = 8704, C_A = 9728;
constexpr int MIX_A = 0, MIX_B = 1024, MIX_C = 3072;
constexpr float EPS = 1e-6f;
constexpr int NSLOT = 1088;
constexpr int ROPE_N = 2064;
constexpr size_t O_YP = 0, O_YS = O_YP + (size_t)MP * D, O_KP = O_YS + (size_t)MS * D, O_VP = O_KP + (size_t)DEPTH * NB * 128 * 256, O_SAP = O_VP + (size_t)DEPTH * NB * 128 * 256,
                 O_SCP = O_SAP + (size_t)DEPTH * NB * 8 * 128 * 128, O_KS = O_SCP + (size_t)DEPTH * NB * 8 * 64 * 128, O_VS = O_KS + (size_t)DEPTH * SB * 16 * 256,
                 O_SAS = O_VS + (size_t)DEPTH * SB * 16 * 256, O_SCS = O_SAS + (size_t)DEPTH * SB * 8 * 128 * 128, O_END = O_SCS + (size_t)DEPTH * SB * 8 * 64 * 128;
constexpr size_t al256(size_t x) { return (x + 255) & ~(size_t)255; }
constexpr size_t WS_CTL = 0, CTL_BYTES = 1u << 20;
constexpr size_t WS_ROPE = WS_CTL + CTL_BYTES;
constexpr size_t WS_LB = WS_ROPE + al256((size_t)ROPE_N * 32 * 2 * 4);
constexpr size_t WS_X = WS_LB + al256(3 * 2 * 1024 * 4);
constexpr size_t WS_XN = WS_X + (size_t)MPAD * D * 4;
constexpr size_t WS_PROJ = WS_XN + (size_t)MPAD * D * 2;
constexpr size_t WS_MIX = WS_PROJ + (size_t)MPAD * INP * 2;
constexpr size_t WS_ACT = WS_MIX + (size_t)MPAD * D * 2;
constexpr size_t WS_W1 = WS_ACT + (size_t)MPAD * DFF * 2;
constexpr size_t WS_W2 = WS_W1 + 2 * (size_t)INP * D * 2;
constexpr size_t WS_W3 = WS_W2 + 2 * (size_t)D * D * 2;
constexpr size_t WS_W4 = WS_W3 + 2 * (size_t)2 * DFF * D * 2;
constexpr size_t WS_UA = WS_W4 + 2 * (size_t)D * DFF * 2;
constexpr size_t WS_UC = WS_UA + (size_t)NSLOT * 128 * 128 * 4;
constexpr size_t WS_DA = WS_UC + (size_t)NSLOT * 128 * 64 * 4;
constexpr size_t WS_DC = WS_DA + (size_t)NSLOT * 128 * 4;
constexpr size_t WS_SSP = WS_DC + (size_t)NSLOT * 64 * 4;
constexpr size_t WS_SSA = WS_SSP + (size_t)MPAD * 64 * 4;
constexpr size_t WS_SSB = WS_SSA + (size_t)MPAD * 4;
constexpr size_t WS_PART = WS_SSB + (size_t)MPAD * 4;
constexpr size_t WS_STA = WS_PART + (size_t)16 * MS * D * 4;
constexpr size_t WS_STC = WS_STA + (size_t)NSLOT * 128 * 128 * 2;
constexpr size_t WS_CAB = WS_STC + (size_t)NSLOT * 128 * 64 * 2;
constexpr size_t WS_GU = WS_CAB + (size_t)MPAD * 16 * 2;
constexpr size_t WS_END = WS_GU + (size_t)MS * 2 * DFF * 4;
constexpr int CW_BAR = 4096, CW_RANK = 8192, CW_FALL = 8192 + 64 * 8;
constexpr int RING_BYTES = 131072;
constexpr int MISC_OFF = RING_BYTES + 320;
constexpr int LDS_BYTES = 147456;
constexpr int NWAVES = 8;

#define GAS __attribute__((address_space(1)))
#define LAS __attribute__((address_space(3)))
typedef unsigned short bf16;
typedef unsigned v4u __attribute__((ext_vector_type(4)));
typedef unsigned v2u __attribute__((ext_vector_type(2)));
typedef float f32x4 __attribute__((ext_vector_type(4)));
typedef short bf16x8 __attribute__((ext_vector_type(8)));
typedef short bf16x4 __attribute__((ext_vector_type(4)));
#define LDS_WAIT() asm volatile("s_waitcnt lgkmcnt(0)" ::: "memory")
#define VM_WAIT() asm volatile("s_waitcnt vmcnt(0)" ::: "memory")
typedef float f32x2_t __attribute__((ext_vector_type(2))); typedef __bf16 bf16x2_t __attribute__((ext_vector_type(2)));
__device__ __forceinline__ unsigned pk2(float lo, float hi) { const f32x2_t v = {lo, hi}; const bf16x2_t b = __builtin_convertvector(v, bf16x2_t); return __builtin_bit_cast(unsigned, b); }
__device__ __forceinline__ unsigned f2bf(float f) { return pk2(f, f) & 0xffffu; }
__device__ __forceinline__ float bf2f(unsigned short b) { return __builtin_bit_cast(float, (unsigned)b << 16); }
__device__ __forceinline__ float bflo(unsigned w) { return __builtin_bit_cast(float, w << 16); }
__device__ __forceinline__ float bfhi(unsigned w) { return __builtin_bit_cast(float, w & 0xffff0000u); }

#define XB_TMO      128
#define XB_XCNT(j)  (256  + 64 * (j))
#define XB_XSUB(j)  (1280 + 64 * (j))
#define XB_XGEN(j)  (2304 + 64 * (j))
#define XB_TOP      3328
#define XB_TOPGEN   3392
#define XCD_BAR_WORDS 3456
#define XB_SPIN_CAP (1u << 18)

__device__ __forceinline__ unsigned xb_ld(unsigned* p)              { return __hip_atomic_load(p, __ATOMIC_RELAXED, __HIP_MEMORY_SCOPE_AGENT); }
__device__ __forceinline__ unsigned xb_add(unsigned* p, unsigned v) { return __hip_atomic_fetch_add(p, v, __ATOMIC_RELAXED, __HIP_MEMORY_SCOPE_AGENT); }
__device__ __forceinline__ unsigned xb_xcc_id() { return (unsigned)__builtin_amdgcn_s_getreg((3 << 11) | 20) & 0xFu; }
#define XB_SPIN(cond, bar) do { unsigned _sp = 0; while (cond) { __builtin_amdgcn_s_sleep(1); \
    if ((++_sp & 255u) == 0u) { if (xb_ld(&(bar)[XB_TMO])) break; if (_sp > XB_SPIN_CAP) { atomicAdd(&(bar)[XB_TMO], 1u); break; } } } } while (0)

struct XcdBarrier {
    unsigned* bar; unsigned x;
    volatile LAS unsigned* st;
};

__device__ __forceinline__ XcdBarrier xcd_barrier_post(unsigned* bar, volatile LAS unsigned* st) {
    XcdBarrier b; b.bar = bar; b.x = xb_xcc_id(); b.st = st;
    if (threadIdx.x == 0) (void)xb_add(&bar[XB_XCNT(b.x)], 1u);
    return b;
}
__device__ __forceinline__ void xcd_barrier_complete(unsigned* bar, unsigned x, unsigned& nloc, unsigned& nx) {
    const unsigned G = gridDim.x * gridDim.y * gridDim.z;
    unsigned sum, cnt, mine, sp = 0u;
    for (;;) {
        sum = 0u; cnt = 0u; mine = 0u;
#pragma unroll
        for (unsigned j = 0; j < 16; ++j) { const unsigned c = xb_ld(&bar[XB_XCNT(j)]); sum += c; cnt += (c > 0u) ? 1u : 0u; mine = (j == x) ? c : mine; }
        if (sum == G) break;
        __builtin_amdgcn_s_sleep(1);
        if ((++sp & 255u) == 0u) { if (xb_ld(&bar[XB_TMO])) break; if (sp > XB_SPIN_CAP) { atomicAdd(&bar[XB_TMO], 1u); break; } }
    }
    nloc = mine > 0u ? mine : 1u; nx = cnt > 0u ? cnt : 1u;
}

__device__ __forceinline__ void xcd_barrier(const XcdBarrier& b) {
    asm volatile("s_waitcnt vmcnt(0)" ::: "memory");
    __syncthreads();
    if (threadIdx.x == 0) {
        unsigned* bar = b.bar;
        __builtin_amdgcn_s_waitcnt(0);
        unsigned nloc = b.st[0], nx = b.st[1];
        if (nloc == 0u) { xcd_barrier_complete(bar, b.x, nloc, nx); b.st[0] = nloc; b.st[1] = nx; }
        const unsigned old = xb_add(&bar[XB_XSUB(b.x)], 1u);
        const unsigned gen = old / nloc;
        if (old + 1u == (gen + 1u) * nloc) {
            __builtin_amdgcn_fence(__ATOMIC_RELEASE, "agent");
            asm volatile("s_waitcnt vmcnt(0)" ::: "memory");
            const unsigned og = xb_add(&bar[XB_TOP], 1u);
            const unsigned tg = og / nx;
            if (og + 1u == (tg + 1u) * nx) xb_add(&bar[XB_TOPGEN], 1u);
            else XB_SPIN(xb_ld(&bar[XB_TOPGEN]) == tg, bar);
            __builtin_amdgcn_fence(__ATOMIC_ACQUIRE, "agent");
            xb_add(&bar[XB_XGEN(b.x)], 1u);
            asm volatile("s_waitcnt vmcnt(0)" ::: "memory");
        } else {
            XB_SPIN(xb_ld(&bar[XB_XGEN(b.x)]) == gen, bar);
            __builtin_amdgcn_fence(__ATOMIC_ACQUIRE, "agent");
            asm volatile("s_waitcnt vmcnt(0)" ::: "memory");
        }
    }
    __syncthreads();
}


struct Args { const float* in[19]; float* out; unsigned char* ws; int ph_lo, ph_hi; };

__device__ __forceinline__ float wave_sum(float v) {
#pragma unroll
    for (int o = 1; o < 64; o <<= 1) v += __shfl_xor(v, o);
    return v;
}

template <int MODE>
__device__ __forceinline__ void transpose_item(const float* W, int K, int N, bf16* WT, const float* gain, int item, int lane) {
    const int nblk = (N + 63) / 64, kb = item / nblk, nb = item - kb * nblk, k0 = 64 * kb, n0 = 64 * nb;
    const int q = lane >> 4, p = lane & 15, n = n0 + 4 * p;
    if (n >= N) return;
    const float* src = W + (size_t)(k0 + 16 * q) * N + n;
    f32x4 v[16];
#pragma unroll
    for (int i = 0; i < 16; ++i) v[i] = *(const f32x4*)(src + (size_t)i * N);
    if (gain) {
#pragma unroll
        for (int i = 0; i < 4; ++i) { const f32x4 g4 = *(const f32x4*)(gain + k0 + 16 * q + 4 * i); v[4 * i] = v[4 * i] * g4.x; v[4 * i + 1] = v[4 * i + 1] * g4.y; v[4 * i + 2] = v[4 * i + 2] * g4.z; v[4 * i + 3] = v[4 * i + 3] * g4.w; } }
#pragma unroll
    for (int cc = 0; cc < 4; ++cc) { const int nn = n + cc; int orow = nn;
        if (MODE == 1) { const int half = nn >= DFF ? 1 : 0, nn2 = nn - half * DFF; orow = 256 * (nn2 >> 7) + 128 * half + (nn2 & 127); }
        unsigned w[8];
#pragma unroll
        for (int i = 0; i < 8; ++i) w[i] = pk2(v[2 * i][cc], v[2 * i + 1][cc]);
        v4u* dst = (v4u*)(WT + (((size_t)(orow >> 7) * (K / 64) + kb) * 128 + (orow & 127)) * 64 + 16 * q); dst[0] = (v4u){w[0], w[1], w[2], w[3]}; dst[1] = (v4u){w[4], w[5], w[6], w[7]}; }
}
template <int MODE>
__device__ __forceinline__ void norm_row(const float* src, const bf16* xsrc, const float* g, bf16* xb, float* ssout, float* fout, int lane) {
    if (MODE == 0) {
        const f32x4* s4 = (const f32x4*)src + lane; f32x4 v[16]; float ss = 0.f;
#pragma unroll
        for (int j = 0; j < 16; ++j) { v[j] = s4[64 * j]; ss += (v[j].x * v[j].x + v[j].y * v[j].y) + (v[j].z * v[j].z + v[j].w * v[j].w); }
        ss = wave_sum(ss);
#pragma unroll
        for (int j = 0; j < 16; ++j) { v2u w; w.x = pk2(v[j].x, v[j].y); w.y = pk2(v[j].z, v[j].w); ((v2u*)xb + lane)[64 * j] = w; }
        if (lane == 0) *ssout = ss;
    } else {
        const v4u* s8 = (const v4u*)xsrc + lane; v4u r[8]; float ss = 0.f;
#pragma unroll
        for (int j = 0; j < 8; ++j) { r[j] = s8[64 * j]; const unsigned rw[4] = {r[j].x, r[j].y, r[j].z, r[j].w};
#pragma unroll
            for (int i = 0; i < 4; ++i) { const float a0 = bflo(rw[i]), a1 = bfhi(rw[i]); ss += a0 * a0 + a1 * a1; } }
        ss = wave_sum(ss);
        const float rstd = 1.0f / sqrtf(ss * (1.0f / D) + EPS);
#pragma unroll
        for (int j = 0; j < 8; ++j) { const unsigned rw[4] = {r[j].x, r[j].y, r[j].z, r[j].w}; const f32x4 g0 = *(const f32x4*)(g + 512 * j + 8 * lane), g1 = *(const f32x4*)(g + 512 * j + 8 * lane + 4);
            *(f32x4*)(fout + 512 * j + 8 * lane) = (f32x4){bflo(rw[0]) * rstd * g0.x, bfhi(rw[0]) * rstd * g0.y, bflo(rw[1]) * rstd * g0.z, bfhi(rw[1]) * rstd * g0.w};
            *(f32x4*)(fout + 512 * j + 8 * lane + 4) = (f32x4){bflo(rw[2]) * rstd * g1.x, bfhi(rw[2]) * rstd * g1.y, bflo(rw[3]) * rstd * g1.z, bfhi(rw[3]) * rstd * g1.w}; }
    }
}
__device__ __forceinline__ void final_rows2(const bf16* XBp, const float* g, float* fout, int m0, int m1, int lane) {
    v4u r[2][8]; float ss[2] = {0.f, 0.f};
#pragma unroll
    for (int k = 0; k < 2; ++k) { const v4u* s8 = (const v4u*)(XBp + (size_t)(k ? m1 : m0) * D) + lane;
#pragma unroll
        for (int j = 0; j < 8; ++j) r[k][j] = s8[64 * j]; }
#pragma unroll
    for (int k = 0; k < 2; ++k)
#pragma unroll
        for (int j = 0; j < 8; ++j) { const unsigned rw[4] = {r[k][j].x, r[k][j].y, r[k][j].z, r[k][j].w};
#pragma unroll
            for (int i = 0; i < 4; ++i) { const float a0 = bflo(rw[i]), a1 = bfhi(rw[i]); ss[k] += a0 * a0 + a1 * a1; } }
    ss[0] = wave_sum(ss[0]); ss[1] = wave_sum(ss[1]);
#pragma unroll
    for (int k = 0; k < 2; ++k) { if (k == 1 && m1 == m0) break; const float rstd = 1.0f / sqrtf(ss[k] * (1.0f / D) + EPS); float* fo = fout + (size_t)(k ? m1 : m0) * D;
#pragma unroll
        for (int j = 0; j < 8; ++j) { const unsigned rw[4] = {r[k][j].x, r[k][j].y, r[k][j].z, r[k][j].w}; const f32x4 g0 = *(const f32x4*)(g + 512 * j + 8 * lane), g1 = *(const f32x4*)(g + 512 * j + 8 * lane + 4);
            __builtin_nontemporal_store((f32x4){bflo(rw[0]) * rstd * g0.x, bfhi(rw[0]) * rstd * g0.y, bflo(rw[1]) * rstd * g0.z, bfhi(rw[1]) * rstd * g0.w}, (f32x4*)(fo + 512 * j + 8 * lane));
            __builtin_nontemporal_store((f32x4){bflo(rw[2]) * rstd * g1.x, bfhi(rw[2]) * rstd * g1.y, bflo(rw[3]) * rstd * g1.z, bfhi(rw[3]) * rstd * g1.w}, (f32x4*)(fo + 512 * j + 8 * lane + 4)); } }
}
__device__ __forceinline__ void prologue(const Args& a, LAS unsigned char* lds, int tid, int lane, int wave, int bid, int G) {
    unsigned char* ws = a.ws;
    const int gw = bid * NWAVES + wave, NGW = G * NWAVES;
    constexpr int I1 = 64 * 153, I2 = 64 * 64, I3 = 64 * 344, I4 = 172 * 64, IL = I1 + I2 + I3 + I4;
    for (int it = gw; it < 2 * IL; it += NGW) {
        const int l = it >= IL ? 1 : 0; int r = it - l * IL;
        if (r < I1) { transpose_item<0>(a.in[7] + (size_t)l * D * INC, D, INC, (bf16*)(ws + WS_W1) + (size_t)l * INP * D, a.in[6] + (size_t)l * D, r, lane); continue; } r -= I1;
        if (r < I2) { transpose_item<0>(a.in[14] + (size_t)l * D * D, D, D, (bf16*)(ws + WS_W2) + (size_t)l * D * D, nullptr, r, lane); continue; } r -= I2;
        if (r < I3) { transpose_item<1>(a.in[16] + (size_t)l * D * 2 * DFF, D, 2 * DFF, (bf16*)(ws + WS_W3) + (size_t)l * 2 * DFF * D, a.in[15] + (size_t)l * D, r, lane); continue; } r -= I3;
        transpose_item<0>(a.in[17] + (size_t)l * DFF * D, DFF, D, (bf16*)(ws + WS_W4) + (size_t)l * D * DFF, nullptr, r, lane);
    }
    const int gt = bid * 512 + tid, NT = G * 512; const v4u z4 = {0u, 0u, 0u, 0u};
    {
      constexpr int NX = (MPAD - MV) * D * 4 / 16, NH = NX / 2;
      for (int i = gt; i < NH; i += NT) { ((v4u*)(ws + WS_XN + (size_t)MV * D * 2))[i] = z4; ((v4u*)(ws + WS_MIX + (size_t)MV * D * 2))[i] = z4; } }
    for (int m = gw; m < MV; m += 2 * NGW) { const int m1 = m + NGW < MV ? m + NGW : m;
        const float* s0 = m < MP ? a.in[0] + (size_t)m * D : a.in[1] + (size_t)(m - MP) * D; const float* s1 = m1 < MP ? a.in[0] + (size_t)m1 * D : a.in[1] + (size_t)(m1 - MP) * D;
        f32x4 v[2][16]; float ss[2] = {0.f, 0.f};
#pragma unroll
        for (int j = 0; j < 16; ++j) { v[0][j] = ((const f32x4*)s0 + lane)[64 * j]; v[1][j] = ((const f32x4*)s1 + lane)[64 * j]; }
#pragma unroll
        for (int k = 0; k < 2; ++k)
#pragma unroll
            for (int j = 0; j < 16; ++j) ss[k] += (v[k][j].x * v[k][j].x + v[k][j].y * v[k][j].y) + (v[k][j].z * v[k][j].z + v[k][j].w * v[k][j].w);
        ss[0] = wave_sum(ss[0]); ss[1] = wave_sum(ss[1]);
#pragma unroll
        for (int k = 0; k < 2; ++k) { if (k == 1 && m1 == m) break; const int mm = k ? m1 : m; bf16* xb = (bf16*)(ws + WS_XN) + (size_t)mm * D;
#pragma unroll
            for (int j = 0; j < 16; ++j) { v2u w; w.x = pk2(v[k][j].x, v[k][j].y); w.y = pk2(v[k][j].z, v[k][j].w); ((v2u*)xb + lane)[64 * j] = w; }
            if (lane == 0) ((float*)(ws + WS_SSA))[mm] = ss[k]; } }
    for (int i = gt; i < MPAD - MV; i += NT) { ((float*)(ws + WS_SSA))[MV + i] = 0.f; ((float*)(ws + WS_SSB))[MV + i] = 0.f; }
    { float* rc = (float*)(ws + WS_ROPE); float* rs = rc + ROPE_N * 32;
      for (int i = gt; i < ROPE_N * 32; i += NT) { const int p = i >> 5, k = i & 31; const float pos = (float)(p < 2048 ? p : 4096 + (p - 2048));
          const float inv = powf(10000.0f, -(float)k / 32.0f); const float ang = pos * inv; float sn, cs; sincosf(ang, &sn, &cs); rc[i] = cs; rs[i] = sn; }
      float* lba = (float*)(ws + WS_LB); float* lbc = lba + 2048; float* lbm = lbc + 2048;
      for (int i = gt; i < 1024; i += NT) { const float z0 = a.in[8][i], z1 = a.in[8][1024 + i], mx = fmaxf(z0, z1), e0 = expf(z0 - mx), e1 = expf(z1 - mx), p0 = e0 / (e0 + e1), p1 = e1 / (e0 + e1);
          const float lb0 = p0 - p0, lb1 = (p0 + p1) - p0;
          lba[i] = logf(fmaxf(lb0, 1e-30f)); lbc[i] = log1pf(-lb0); lbm[i] = 1.0f - lb0;
          lba[1024 + i] = logf(fmaxf(lb1, 1e-30f)); lbc[1024 + i] = log1pf(-lb1); lbm[1024 + i] = 1.0f - lb1; } }
}

template <int KSTEPS>
__device__ __forceinline__ f32x4 tile_mma(f32x4 acc, const LAS bf16* Xrow, const LAS bf16* Yrow) {
#pragma unroll
    for (int ks = 0; ks < KSTEPS; ++ks) { const bf16x8 x = *(const LAS bf16x8*)(Xrow + 32 * ks), y = *(const LAS bf16x8*)(Yrow + 32 * ks);
        acc = __builtin_amdgcn_mfma_f32_16x16x32_bf16(x, y, acc, 0, 0, 0); }
    return acc;
}

#define LBAR() do { asm volatile("s_waitcnt lgkmcnt(0)" ::: "memory"); __builtin_amdgcn_s_barrier(); asm volatile("" ::: "memory"); } while (0)
__device__ __forceinline__ void swa_item(const Args& a, LAS unsigned char* lds, int l, int item, int tid, int lane, int wave) {
    unsigned char* ws = a.ws;
    const bf16* PROJ = (const bf16*)(ws + WS_PROJ); bf16* MIX = (bf16*)(ws + WS_MIX);
    const float* rc = (const float*)(ws + WS_ROPE); const float* rs = rc + ROPE_N * 32;
    LAS bf16* Ks = (LAS bf16*)lds;
    LAS bf16* Vt = (LAS bf16*)(lds + 27648);
    const bool samp = item >= 512;
    int b, kvh, c;
    if (!samp) { kvh = item & 3; c = (item >> 2) & 31; b = item >> 7; } else { const int j = item - 512; kvh = j & 3; b = j >> 2; c = 0; }
#pragma unroll 4
    for (int i = 0; i < 12; ++i) { const int p = tid + 512 * i, key = p >> 5, pi = p & 31, blk = key >> 6, kr = key & 63; float r1 = 0.f, r2 = 0.f;
        if (!samp) { const int cj = c - 2 + blk;
            if (cj >= 0) { const size_t row = (size_t)b * TT + cj * 64 + kr; const bf16* kp = PROJ + row * INP + B_K + kvh * 64 + pi; const float k1 = bf2f(kp[0]), k2 = bf2f(kp[32]);
                const int pidx = (cj * 64 + kr) * 32 + pi; const float cs = rc[pidx], sn = rs[pidx]; r1 = k1 * cs - k2 * sn; r2 = k2 * cs + k1 * sn;
                if (blk == 2 && c >= 30) { float* ko = a.out + O_KP + ((((size_t)l * NB + b) * 128 + (c - 30) * 64 + kr) * 4 + kvh) * 64 + pi; ko[0] = r1; ko[32] = r2; } }
        } else {
            if (blk < 2) { const float* kp = a.in[2] + ((((size_t)l * SB + b) * 128 + blk * 64 + kr) * 4 + kvh) * 64 + pi; r1 = kp[0]; r2 = kp[32]; }
            else if (kr < 16) { const size_t row = (size_t)MP + b * 16 + kr; const bf16* kp = PROJ + row * INP + B_K + kvh * 64 + pi; const float k1 = bf2f(kp[0]), k2 = bf2f(kp[32]);
                const int pidx = (2048 + kr) * 32 + pi; const float cs = rc[pidx], sn = rs[pidx]; r1 = k1 * cs - k2 * sn; r2 = k2 * cs + k1 * sn;
                float* ko = a.out + O_KS + ((((size_t)l * SB + b) * 16 + kr) * 4 + kvh) * 64 + pi; ko[0] = r1; ko[32] = r2; }
        }
        Ks[key * 72 + pi] = (bf16)f2bf(r1); Ks[key * 72 + pi + 32] = (bf16)f2bf(r2); }
#pragma unroll 4
    for (int i = 0; i < 24; ++i) { const int e = tid + 512 * i, key = e >> 6, d = e & 63, blk = key >> 6, kr = key & 63; float v = 0.f;
        if (!samp) { const int cj = c - 2 + blk;
            if (cj >= 0) { const size_t row = (size_t)b * TT + cj * 64 + kr; v = bf2f(PROJ[row * INP + B_V + kvh * 64 + d]);
                if (blk == 2 && c >= 30) a.out[O_VP + ((((size_t)l * NB + b) * 128 + (c - 30) * 64 + kr) * 4 + kvh) * 64 + d] = v; }
        } else {
            if (blk < 2) v = a.in[3][((((size_t)l * SB + b) * 128 + blk * 64 + kr) * 4 + kvh) * 64 + d];
            else if (kr < 16) { const size_t row = (size_t)MP + b * 16 + kr; v = bf2f(PROJ[row * INP + B_V + kvh * 64 + d]);
                a.out[O_VS + ((((size_t)l * SB + b) * 16 + kr) * 4 + kvh) * 64 + d] = v; }
        }
        Vt[d * 200 + key] = (bf16)f2bf(v); }
    __syncthreads();
    const int fr = lane & 15, fq = lane >> 4, hq = kvh * 8 + wave;
    const float sink = a.in[10][l * 32 + hq];
    unsigned tvm;
    if (!samp) tvm = c >= 2 ? 0xfffu : (c == 1 ? 0xff0u : 0xf00u); else tvm = 0x1ffu;
    const int nmb = samp ? 1 : 4;
    for (int mb = 0; mb < nmb; ++mb) {
        const size_t qrow = samp ? (size_t)MP + b * 16 + fr : (size_t)b * TT + c * 64 + 16 * mb + fr;
        const int pidx = (samp ? 2048 + fr : c * 64 + 16 * mb + fr) * 32 + 8 * fq;
        const v4u x1 = *(const v4u*)(PROJ + qrow * INP + B_Q + hq * 64 + 8 * fq), x2 = *(const v4u*)(PROJ + qrow * INP + B_Q + hq * 64 + 32 + 8 * fq);
        const f32x4 c0 = *(const f32x4*)(rc + pidx), c1 = *(const f32x4*)(rc + pidx + 4), s0 = *(const f32x4*)(rs + pidx), s1 = *(const f32x4*)(rs + pidx + 4);
        const float cs[8] = {c0.x, c0.y, c0.z, c0.w, c1.x, c1.y, c1.z, c1.w}, sn[8] = {s0.x, s0.y, s0.z, s0.w, s1.x, s1.y, s1.z, s1.w};
        const unsigned xa[4] = {x1.x, x1.y, x1.z, x1.w}, xb[4] = {x2.x, x2.y, x2.z, x2.w};
        unsigned qa[4], qb[4];
#pragma unroll
        for (int j = 0; j < 4; ++j) { const float a0 = bflo(xa[j]), a1 = bfhi(xa[j]), b0 = bflo(xb[j]), b1 = bfhi(xb[j]);
            qa[j] = pk2(a0 * cs[2 * j] - b0 * sn[2 * j], a1 * cs[2 * j + 1] - b1 * sn[2 * j + 1]);
            qb[j] = pk2(b0 * cs[2 * j] + a0 * sn[2 * j], b1 * cs[2 * j + 1] + a1 * sn[2 * j + 1]); }
        const bf16x8 bq0 = __builtin_bit_cast(bf16x8, (v4u){qa[0], qa[1], qa[2], qa[3]}), bq1 = __builtin_bit_cast(bf16x8, (v4u){qb[0], qb[1], qb[2], qb[3]});
        f32x4 s[12]; float mx = sink;
#pragma unroll
        for (int kt = 0; kt < 12; ++kt) { s[kt] = (f32x4){0.f, 0.f, 0.f, 0.f};
            if ((tvm >> kt) & 1u) { const LAS bf16* kp = Ks + (16 * kt + fr) * 72 + 8 * fq;
                f32x4 acc = __builtin_amdgcn_mfma_f32_16x16x32_bf16(*(const LAS bf16x8*)kp, bq0, (f32x4){0.f, 0.f, 0.f, 0.f}, 0, 0, 0);
                acc = __builtin_amdgcn_mfma_f32_16x16x32_bf16(*(const LAS bf16x8*)(kp + 32), bq1, acc, 0, 0, 0);
                s[kt] = acc * 0.125f; mx = fmaxf(mx, fmaxf(fmaxf(s[kt].x, s[kt].y), fmaxf(s[kt].z, s[kt].w))); } }
        mx = fmaxf(mx, __shfl_xor(mx, 16)); mx = fmaxf(mx, __shfl_xor(mx, 32));
        float sum = 0.f;
#pragma unroll
        for (int kt = 0; kt < 12; ++kt) { if ((tvm >> kt) & 1u) { s[kt].x = __expf(s[kt].x - mx); s[kt].y = __expf(s[kt].y - mx); s[kt].z = __expf(s[kt].z - mx); s[kt].w = __expf(s[kt].w - mx);
                sum += (s[kt].x + s[kt].y) + (s[kt].z + s[kt].w); } }
        sum += __shfl_xor(sum, 16); sum += __shfl_xor(sum, 32); sum += __expf(sink - mx);
        const float inv = 1.0f / sum;
        f32x4 o[4];
#pragma unroll
        for (int dt = 0; dt < 4; ++dt) o[dt] = (f32x4){0.f, 0.f, 0.f, 0.f};
#pragma unroll
        for (int u = 0; u < 6; ++u) { if ((tvm >> (2 * u)) & 3u) {
                const bf16x8 bp = __builtin_bit_cast(bf16x8, (v4u){pk2(s[2 * u].x, s[2 * u].y), pk2(s[2 * u].z, s[2 * u].w), pk2(s[2 * u + 1].x, s[2 * u + 1].y), pk2(s[2 * u + 1].z, s[2 * u + 1].w)});
#pragma unroll
                for (int dt = 0; dt < 4; ++dt) { const LAS bf16* vp = Vt + (16 * dt + fr) * 200 + 32 * u + 4 * fq;
                    const v2u lo = *(const LAS v2u*)vp, hi = *(const LAS v2u*)(vp + 16);
                    o[dt] = __builtin_amdgcn_mfma_f32_16x16x32_bf16(__builtin_bit_cast(bf16x8, (v4u){lo.x, lo.y, hi.x, hi.y}), bp, o[dt], 0, 0, 0); } } }
        bf16* op = MIX + qrow * D + MIX_B + hq * 64 + 4 * fq;
#pragma unroll
        for (int dt = 0; dt < 4; ++dt) { v2u w; w.x = pk2(o[dt].x * inv, o[dt].y * inv); w.y = pk2(o[dt].z * inv, o[dt].w * inv); *(v2u*)(op + 16 * dt) = w; }
    }
    __syncthreads();
}

__device__ __forceinline__ void swa_prompt_item(const Args& a, LAS unsigned char* lds, int l, int item, int tid, int lane, int wave) {
    unsigned char* ws = a.ws;
    const bf16* PROJ = (const bf16*)(ws + WS_PROJ); bf16* MIX = (bf16*)(ws + WS_MIX);
    const float* rc = (const float*)(ws + WS_ROPE); const float* rs = rc + ROPE_N * 32;
    LAS bf16* Ks = (LAS bf16*)lds;
    LAS bf16* Vr = (LAS bf16*)(lds + 27648);
    LAS bf16* Vt = (LAS bf16*)(lds + 55296);
    LAS float* Cc = (LAS float*)(lds + 80896);
    LAS float* Cs = Cc + 64 * 32;
    const int kvh = item & 3, c = (item >> 2) & 31, b = item >> 7;
    const int fr = lane & 15, fq = lane >> 4, hq = kvh * 8 + wave;
    const v4u z4 = {0u, 0u, 0u, 0u}; const f32x4 zf = {0.f, 0.f, 0.f, 0.f};
    v4u kreg[3], vreg[3]; f32x4 creg[3], sreg[3], xq[4][2];
#pragma unroll
    for (int j = 0; j < 3; ++j) { const int ci = tid + 512 * j, key = ci >> 3, c8 = ci & 7, cj = c - 2 + (key >> 6); kreg[j] = z4; vreg[j] = z4; creg[j] = zf; sreg[j] = zf;
        if (cj >= 0) { const bf16* p = PROJ + ((size_t)b * TT + cj * 64 + (key & 63)) * INP + kvh * 64 + 8 * c8; kreg[j] = *(const v4u*)(p + B_K); vreg[j] = *(const v4u*)(p + B_V);
            const int pidx = (cj * 64 + (key & 63)) * 32 + 4 * c8; creg[j] = *(const f32x4*)(rc + pidx); sreg[j] = *(const f32x4*)(rs + pidx); } }
#pragma unroll
    for (int mb = 0; mb < 4; ++mb) { const bf16* p = PROJ + ((size_t)b * TT + c * 64 + 16 * mb + fr) * INP + B_Q + hq * 64 + 8 * fq; xq[mb][0] = __builtin_bit_cast(f32x4, *(const v4u*)p); xq[mb][1] = __builtin_bit_cast(f32x4, *(const v4u*)(p + 32)); }
    const float sink = a.in[10][l * 32 + hq];
#pragma unroll
    for (int j = 0; j < 3; ++j) { const int ci = tid + 512 * j, key = ci >> 3, c8 = ci & 7; *(LAS v4u*)(Ks + key * 72 + 8 * c8) = kreg[j]; *(LAS v4u*)(Vr + key * 72 + 8 * c8) = vreg[j];
        if ((key >> 6) == 2 && c >= 30) { float* vo = a.out + O_VP + ((((size_t)l * NB + b) * 128 + (c - 30) * 64 + (key & 63)) * 4 + kvh) * 64 + 8 * c8;
            *(f32x4*)vo = (f32x4){bflo(vreg[j].x), bfhi(vreg[j].x), bflo(vreg[j].y), bfhi(vreg[j].y)}; *(f32x4*)(vo + 4) = (f32x4){bflo(vreg[j].z), bfhi(vreg[j].z), bflo(vreg[j].w), bfhi(vreg[j].w)}; } }
    LBAR();
#pragma unroll
    for (int j = 0; j < 3; ++j) { const int e = tid + 512 * j, key = e >> 3, i4 = (e & 7) * 4;
        const v2u k1 = *(const LAS v2u*)(Ks + key * 72 + i4), k2 = *(const LAS v2u*)(Ks + key * 72 + 32 + i4);
        const float a0 = bflo(k1.x), a1 = bfhi(k1.x), a2 = bflo(k1.y), a3 = bfhi(k1.y), b0 = bflo(k2.x), b1 = bfhi(k2.x), b2 = bflo(k2.y), b3 = bfhi(k2.y);
        const f32x4 cs = creg[j], sn = sreg[j];
        const f32x4 r1 = {a0 * cs.x - b0 * sn.x, a1 * cs.y - b1 * sn.y, a2 * cs.z - b2 * sn.z, a3 * cs.w - b3 * sn.w}, r2 = {b0 * cs.x + a0 * sn.x, b1 * cs.y + a1 * sn.y, b2 * cs.z + a2 * sn.z, b3 * cs.w + a3 * sn.w};
        *(LAS v2u*)(Ks + key * 72 + i4) = (v2u){pk2(r1.x, r1.y), pk2(r1.z, r1.w)}; *(LAS v2u*)(Ks + key * 72 + 32 + i4) = (v2u){pk2(r2.x, r2.y), pk2(r2.z, r2.w)};
        if ((key >> 6) == 2) { *(LAS f32x4*)(Cc + (key & 63) * 32 + i4) = cs; *(LAS f32x4*)(Cs + (key & 63) * 32 + i4) = sn;
            if (c >= 30) { float* ko = a.out + O_KP + ((((size_t)l * NB + b) * 128 + (c - 30) * 64 + (key & 63)) * 4 + kvh) * 64 + i4; *(f32x4*)ko = r1; *(f32x4*)(ko + 32) = r2; } } }
    { const int d = tid & 63, kp = tid >> 6; unsigned w[12];
#pragma unroll
      for (int i = 0; i < 12; ++i) w[i] = (unsigned)Vr[(24 * kp + 2 * i) * 72 + d] | ((unsigned)Vr[(24 * kp + 2 * i + 1) * 72 + d] << 16);
      LAS v4u* dst = (LAS v4u*)(Vt + d * 200 + 24 * kp); dst[0] = (v4u){w[0], w[1], w[2], w[3]}; dst[1] = (v4u){w[4], w[5], w[6], w[7]}; dst[2] = (v4u){w[8], w[9], w[10], w[11]}; }
    LBAR();
    const unsigned tvm = c >= 2 ? 0xfffu : (c == 1 ? 0xff0u : 0xf00u);
#pragma unroll
    for (int mb = 0; mb < 4; ++mb) {
        const size_t qrow = (size_t)b * TT + c * 64 + 16 * mb + fr;
        const LAS float* cp = Cc + (16 * mb + fr) * 32 + 8 * fq; const LAS float* sp = Cs + (16 * mb + fr) * 32 + 8 * fq;
        const f32x4 c0 = *(const LAS f32x4*)cp, c1 = *(const LAS f32x4*)(cp + 4), s0 = *(const LAS f32x4*)sp, s1 = *(const LAS f32x4*)(sp + 4);
        const float cs[8] = {c0.x, c0.y, c0.z, c0.w, c1.x, c1.y, c1.z, c1.w}, sn[8] = {s0.x, s0.y, s0.z, s0.w, s1.x, s1.y, s1.z, s1.w};
        const f32x4 q1 = xq[mb][0], q2 = xq[mb][1];
        const v4u x1 = __builtin_bit_cast(v4u, q1), x2 = __builtin_bit_cast(v4u, q2);
        const unsigned xa[4] = {x1.x, x1.y, x1.z, x1.w}, xb[4] = {x2.x, x2.y, x2.z, x2.w};
        unsigned qa[4], qb[4];
#pragma unroll
        for (int j = 0; j < 4; ++j) { const float a0 = bflo(xa[j]), a1 = bfhi(xa[j]), b0 = bflo(xb[j]), b1 = bfhi(xb[j]);
            qa[j] = pk2(a0 * cs[2 * j] - b0 * sn[2 * j], a1 * cs[2 * j + 1] - b1 * sn[2 * j + 1]);
            qb[j] = pk2(b0 * cs[2 * j] + a0 * sn[2 * j], b1 * cs[2 * j + 1] + a1 * sn[2 * j + 1]); }
        const bf16x8 bq0 = __builtin_bit_cast(bf16x8, (v4u){qa[0], qa[1], qa[2], qa[3]}), bq1 = __builtin_bit_cast(bf16x8, (v4u){qb[0], qb[1], qb[2], qb[3]});
        f32x4 s[12]; float mx = sink;
#pragma unroll
        for (int kt = 0; kt < 12; ++kt) { s[kt] = (f32x4){0.f, 0.f, 0.f, 0.f};
            if ((tvm >> kt) & 1u) { const LAS bf16* kp = Ks + (16 * kt + fr) * 72 + 8 * fq;
                f32x4 acc = __builtin_amdgcn_mfma_f32_16x16x32_bf16(*(const LAS bf16x8*)kp, bq0, (f32x4){0.f, 0.f, 0.f, 0.f}, 0, 0, 0);
                acc = __builtin_amdgcn_mfma_f32_16x16x32_bf16(*(const LAS bf16x8*)(kp + 32), bq1, acc, 0, 0, 0);
                s[kt] = acc * 0.125f; mx = fmaxf(mx, fmaxf(fmaxf(s[kt].x, s[kt].y), fmaxf(s[kt].z, s[kt].w))); } }
        mx = fmaxf(mx, __shfl_xor(mx, 16)); mx = fmaxf(mx, __shfl_xor(mx, 32));
        float sum = 0.f;
#pragma unroll
        for (int kt = 0; kt < 12; ++kt) { if ((tvm >> kt) & 1u) { s[kt].x = __expf(s[kt].x - mx); s[kt].y = __expf(s[kt].y - mx); s[kt].z = __expf(s[kt].z - mx); s[kt].w = __expf(s[kt].w - mx);
                sum += (s[kt].x + s[kt].y) + (s[kt].z + s[kt].w); } }
        sum += __shfl_xor(sum, 16); sum += __shfl_xor(sum, 32); sum += __expf(sink - mx);
        const float inv = 1.0f / sum;
        f32x4 o[4];
#pragma unroll
        for (int dt = 0; dt < 4; ++dt) o[dt] = (f32x4){0.f, 0.f, 0.f, 0.f};
#pragma unroll
        for (int u = 0; u < 6; ++u) { if ((tvm >> (2 * u)) & 3u) {
                const bf16x8 bp = __builtin_bit_cast(bf16x8, (v4u){pk2(s[2 * u].x, s[2 * u].y), pk2(s[2 * u].z, s[2 * u].w), pk2(s[2 * u + 1].x, s[2 * u + 1].y), pk2(s[2 * u + 1].z, s[2 * u + 1].w)});
#pragma unroll
                for (int dt = 0; dt < 4; ++dt) { const LAS bf16* vp = Vt + (16 * dt + fr) * 200 + 32 * u + 4 * fq;
                    const v2u lo = *(const LAS v2u*)vp, hi = *(const LAS v2u*)(vp + 16);
                    o[dt] = __builtin_amdgcn_mfma_f32_16x16x32_bf16(__builtin_bit_cast(bf16x8, (v4u){lo.x, lo.y, hi.x, hi.y}), bp, o[dt], 0, 0, 0); } } }
        bf16* op = MIX + qrow * D + MIX_B + hq * 64 + 4 * fq;
#pragma unroll
        for (int dt = 0; dt < 4; ++dt) { v2u w; w.x = pk2(o[dt].x * inv, o[dt].y * inv); w.y = pk2(o[dt].z * inv, o[dt].w * inv); *(v2u*)(op + 16 * dt) = w; }
    }
    LBAR();
}

struct SeqItem { int row0, nvalid, slot, h; };
__device__ __forceinline__ SeqItem seq_item(int j) {
    SeqItem it;
    if (j < 1024) { it.h = j & 7; const int bc = j >> 3, c = bc & 31, b = bc >> 5; it.row0 = b * TT + c * 64; it.nvalid = 64; it.slot = (b * 8 + it.h) * 32 + c; }
    else { const int js = j - 1024; it.h = js & 7; const int sb = js >> 3; it.row0 = MP + sb * 16; it.nvalid = 16; it.slot = 1024 + js; }
    return it;
}
template <bool ISA> struct RC { static constexpr int DK = ISA ? 128 : 64, NPART = 512 / DK, RPP = 64 / NPART, PK = DK + 8, NQ = ISA ? 2 : 1, NS = ISA ? 4 : 2; };
template <bool ISA> struct MixRegs { v4u q[RC<ISA>::NQ], z[RC<ISA>::NQ]  , v[2], ca; float c0, c1, c2; };
template <bool ISA, bool P3>
__device__ __forceinline__ void mix_load(MixRegs<ISA>& R, const Args& a, int l, int j, int tid) {
    constexpr int DK = RC<ISA>::DK;
    const SeqItem it = seq_item(j); const bf16* PROJ = (const bf16*)(a.ws + WS_PROJ); const v4u z4 = {0u, 0u, 0u, 0u};
    if (ISA) {
#pragma unroll
        for (int jj = 0; jj < 2; ++jj) { const int ci = tid + 512 * jj, row = ci >> 4, c8 = ci & 15; const bool ok = row < it.nvalid; const bf16* p = PROJ + (size_t)(it.row0 + row) * INP + it.h * 128 + 8 * c8;
            if (P3) R.q[jj] = ok ? *(const v4u*)(p + A_Q) : z4;
            R.z[jj] = ok ? *(const v4u*)(p + A_F) : z4; R.v[jj] = ok ? *(const v4u*)(p + A_I) : z4; }
        const float* lba = (const float*)(a.ws + WS_LB); const int ci = l * 1024 + it.h * 128 + (tid & 127);
        R.c0 = lba[ci]; R.c1 = lba[2048 + ci]; R.c2 = lba[4096 + ci];
    } else {
        { const int row = tid >> 3, c8 = tid & 7; const bool ok = row < it.nvalid; const bf16* p = PROJ + (size_t)(it.row0 + row) * INP + it.h * 64 + 8 * c8;
          if (P3) R.q[0] = ok ? *(const v4u*)(p + C_Q) : z4;
          R.z[0] = ok ? *(const v4u*)(p + C_K) : z4; }
#pragma unroll
        for (int jj = 0; jj < 2; ++jj) { const int ci = tid + 512 * jj, row = ci >> 4, c8 = ci & 15; R.v[jj] = row < it.nvalid ? *(const v4u*)(PROJ + (size_t)(it.row0 + row) * INP + C_V + it.h * 128 + 8 * c8) : z4; }
        { const int row = (tid >> 1) & 63, hf = tid & 1; R.ca = row < it.nvalid ? *(const v4u*)((const bf16*)(a.ws + WS_CAB) + (size_t)(it.row0 + row) * 16 + 8 * hf) : z4; }
    }
}
struct GlaW { float w2[16]; float ba; };
__device__ __forceinline__ void gla_w_load(GlaW& W, const Args& a, int l, int h, int tid) {
#pragma unroll
    for (int jj = 0; jj < 16; ++jj) W.w2[jj] = a.in[11][((size_t)l * 16 + jj) * 512 + h * 64 + (tid & 63)];
    W.ba = a.in[12][l * 512 + h * 64 + (tid & 63)];
}
template <bool ISA> struct ML { static constexpr int PK = RC<ISA>::PK, QD = 0, KD = QD + 64 * PK * 2, QE = KD + 64 * PK * 2, ST = QE + 64 * PK * 2, VT = ST + 128 * PK * 2, ATT = VT + 128 * 72 * 2, TOT = ATT + 64 * 72 * 2,
    KT = 0  , RAW = ISA ? ST : TOT + 2048, RQ = RAW, RZ = RQ + 64 * PK * 2, RV = RZ + 64 * PK * 2, RCA = RV + 64 * 136 * 2, END = RCA + 64 * 24 * 2,
    P1_VT = 18432, P1_TOT = 36864, P1_RZ = 38912, P1_RV = P1_RZ + 64 * PK * 2, P1_RCA = P1_RV + 64 * 136 * 2; };
static_assert(ML<true>::RV + 64 * 136 * 2 <= ML<true>::ATT && ML<false>::END <= RING_BYTES && ML<true>::TOT + 2048 <= RING_BYTES, "mixer LDS map");
template <bool ISA, bool P3>
__device__ __forceinline__ void mix_stage(const MixRegs<ISA>& R, const GlaW& W, LAS unsigned char* lds, int tid, float (&zr)[RC<ISA>::RPP], float (&gl)[RC<ISA>::RPP], unsigned (&vw)[8]) {
    constexpr int DK = RC<ISA>::DK, RPP = RC<ISA>::RPP, PK = RC<ISA>::PK;
    LAS bf16* rq = (LAS bf16*)(lds + (P3 ? ML<ISA>::RQ : 0)); LAS bf16* rz = (LAS bf16*)(lds + (P3 ? ML<ISA>::RZ : ML<ISA>::P1_RZ)); LAS bf16* rv = (LAS bf16*)(lds + (P3 ? ML<ISA>::RV : ML<ISA>::P1_RV));
    LAS bf16* rca = (LAS bf16*)(lds + (P3 ? ML<ISA>::RCA : ML<ISA>::P1_RCA));
    if (ISA) {
#pragma unroll
        for (int jj = 0; jj < 2; ++jj) { const int ci = tid + 512 * jj, row = ci >> 4, c8 = ci & 15;
            if (P3) *(LAS v4u*)(rq + row * PK + 8 * c8) = R.q[jj];
            *(LAS v4u*)(rz + row * PK + 8 * c8) = R.z[jj]; *(LAS v4u*)(rv + row * 136 + 8 * c8) = R.v[jj]; }
    } else {
        { const int row = tid >> 3, c8 = tid & 7; if (P3) *(LAS v4u*)(rq + row * PK + 8 * c8) = R.q[0]; *(LAS v4u*)(rz + row * PK + 8 * c8) = R.z[0]; }
#pragma unroll
        for (int jj = 0; jj < 2; ++jj) { const int ci = tid + 512 * jj, row = ci >> 4, c8 = ci & 15; *(LAS v4u*)(rv + row * 136 + 8 * c8) = R.v[jj]; }
        if (tid < 128) *(LAS v4u*)(rca + (tid >> 1) * 24 + 8 * (tid & 1)) = R.ca;
    }
    LBAR();
    const int col = tid & (DK - 1), r0 = (tid / DK) * RPP;
#pragma unroll
    for (int i = 0; i < RPP; ++i) { zr[i] = bf2f(rz[(r0 + i) * PK + col]); gl[i] = 0.f; }
    if (!ISA) {
#pragma unroll
        for (int i = 0; i < RPP; ++i) { const v4u c0 = *(const LAS v4u*)(rca + (r0 + i) * 24), c1 = *(const LAS v4u*)(rca + (r0 + i) * 24 + 8); const unsigned cw[8] = {c0.x, c0.y, c0.z, c0.w, c1.x, c1.y, c1.z, c1.w};
            float g = W.ba;
#pragma unroll
            for (int jj = 0; jj < 8; ++jj) g += bflo(cw[jj]) * W.w2[2 * jj] + bfhi(cw[jj]) * W.w2[2 * jj + 1];
            gl[i] = g; } }
    { const int vc = tid & 127, vp = tid >> 7;
#pragma unroll
      for (int i = 0; i < 8; ++i) vw[i] = (unsigned)rv[(16 * vp + 2 * i) * 136 + vc] | ((unsigned)rv[(16 * vp + 2 * i + 1) * 136 + vc] << 16); }
}
template <bool ISA>
__device__ __forceinline__ void mix_gates(const MixRegs<ISA>& R, int nvalid, LAS float* tot, int tid, const float (&zr)[RC<ISA>::RPP], const float (&gl)[RC<ISA>::RPP], float (&cum)[RC<ISA>::RPP], float (&kk)[RC<ISA>::RPP], float& last, float& cref) {
    constexpr int DK = RC<ISA>::DK, NPART = RC<ISA>::NPART, RPP = RC<ISA>::RPP;
    const int col = tid & (DK - 1), part = tid / DK, r0 = part * RPP; float run = 0.f;
    const float lbf = fmaxf(1.0f - R.c2, 1e-30f);
#pragma unroll
    for (int i = 0; i < RPP; ++i) { float lf = 0.f, kv = 0.f;
        if (r0 + i < nvalid) {
            if (ISA) { const float z = zr[i], e = __expf(-fabsf(z)), t = __builtin_amdgcn_rcpf(1.0f + e);
                const float f = lbf + R.c2 * ((z >= 0.f ? 1.0f : e) * t);
                lf = __logf(f); kv = R.c2 * ((z >= 0.f ? e : 1.0f) * t); }
            else { const float g = gl[i]; lf = (fminf(g, 0.f) - __logf(1.0f + __expf(-fabsf(g)))) * (1.0f / 16.0f); kv = zr[i]; } }
        run += lf; cum[i] = run; kk[i] = kv; }
    tot[part * DK + col] = run;
    LBAR();
    float off = 0.f, tl = 0.f, cr = 0.f;
#pragma unroll
    for (int p = 0; p < NPART; ++p) { const float t = tot[p * DK + col]; if (p < part) off += t; if (p < NPART / 2) cr += t; tl += t; }
#pragma unroll
    for (int i = 0; i < RPP; ++i) cum[i] += off;
    last = tl; cref = cr;
}
template <bool ISA>
__device__ __forceinline__ void pass1_compute(const MixRegs<ISA>& R, const GlaW& W, const Args& a, LAS unsigned char* lds, int j, int tid, int lane, int wave) {
    constexpr int DK = RC<ISA>::DK, RPP = RC<ISA>::RPP;
    const SeqItem it = seq_item(j);
    LAS bf16* kT = (LAS bf16*)lds;
    LAS bf16* vT = (LAS bf16*)(lds + ML<ISA>::P1_VT);
    LAS float* tot = (LAS float*)(lds + ML<ISA>::P1_TOT);
    float zr[RPP], gl[RPP], cum[RPP], kk[RPP], last, cref; unsigned vw[8];
    mix_stage<ISA, false>(R, W, lds, tid, zr, gl, vw);
    mix_gates<ISA>(R, it.nvalid, tot, tid, zr, gl, cum, kk, last, cref);
    const int col = tid & (DK - 1), part = tid / DK, r0 = part * RPP;
    { unsigned w[RPP / 2];
#pragma unroll
      for (int i = 0; i < RPP / 2; ++i) w[i] = pk2(kk[2 * i] * __expf(last - cum[2 * i]), kk[2 * i + 1] * __expf(last - cum[2 * i + 1]));
      LAS v4u* dst = (LAS v4u*)(kT + col * 72 + r0);
#pragma unroll
      for (int i = 0; i < RPP / 8; ++i) dst[i] = (v4u){w[4 * i], w[4 * i + 1], w[4 * i + 2], w[4 * i + 3]}; }
    if (part == 0) ((float*)(a.ws + (ISA ? WS_DA : WS_DC)))[(size_t)it.slot * DK + col] = __expf(last);
    { LAS v4u* dst = (LAS v4u*)(vT + (tid & 127) * 72 + 16 * (tid >> 7)); dst[0] = (v4u){vw[0], vw[1], vw[2], vw[3]}; dst[1] = (v4u){vw[4], vw[5], vw[6], vw[7]}; }
    LBAR();
    const int fr = lane & 15, fq = lane >> 4;
    bf16* U = (bf16*)(a.ws + (ISA ? WS_UA : WS_UC)) + (size_t)it.slot * 128 * DK;
    const LAS bf16* vrow = vT + (16 * wave + fr) * 72 + 8 * fq;
#pragma unroll
    for (int nt = 0; nt < DK / 16; ++nt) { const f32x4 acc = tile_mma<2>((f32x4){0.f, 0.f, 0.f, 0.f}, kT + (16 * nt + fr) * 72 + 8 * fq, vrow);
        *(v2u*)(U + (size_t)(16 * wave + fr) * DK + 16 * nt + 4 * fq) = (v2u){pk2(acc.x, acc.y), pk2(acc.z, acc.w)}; }
    LBAR();
}
template <bool ISA>
__device__ __forceinline__ void pass3_compute(const MixRegs<ISA>& R, const GlaW& W, const Args& a, LAS unsigned char* lds, int l, int j, int tid, int lane, int wave) {
    constexpr int DK = RC<ISA>::DK, RPP = RC<ISA>::RPP, PK = RC<ISA>::PK;
    const SeqItem it = seq_item(j);
    LAS bf16* qd = (LAS bf16*)(lds + ML<ISA>::QD); LAS bf16* kd = (LAS bf16*)(lds + ML<ISA>::KD); LAS bf16* qe = (LAS bf16*)(lds + ML<ISA>::QE); LAS bf16* sT = (LAS bf16*)(lds + ML<ISA>::ST);
    LAS bf16* vT = (LAS bf16*)(lds + ML<ISA>::VT); LAS bf16* att = (LAS bf16*)(lds + ML<ISA>::ATT); LAS float* tot = (LAS float*)(lds + ML<ISA>::TOT);
    LAS float* ofl = (LAS float*)lds;
    float zr[RPP], gl[RPP], cum[RPP], kk[RPP], last, cref; unsigned vw[8];
    mix_stage<ISA, true>(R, W, lds, tid, zr, gl, vw);
    v4u sreg[RC<ISA>::NS];
    { const bf16* S = (const bf16*)(a.ws + (ISA ? WS_STA : WS_STC)) + (size_t)it.slot * 128 * DK;
#pragma unroll
      for (int i = 0; i < RC<ISA>::NS; ++i) sreg[i] = *(const v4u*)(S + (size_t)8 * (tid + 512 * i)); }
    mix_gates<ISA>(R, it.nvalid, tot, tid, zr, gl, cum, kk, last, cref);
    const int col = tid & (DK - 1), part = tid / DK, r0 = part * RPP;
    { const LAS bf16* rq = (const LAS bf16*)(lds + ML<ISA>::RQ);
#pragma unroll
      for (int i = 0; i < RPP; ++i) { const int r = r0 + i; const float q = bf2f(rq[r * PK + col]) * (ISA ? 1.0f : 0.125f);
          const float e1 = __expf(cum[i] - cref);
          qd[r * PK + col] = (bf16)f2bf(q * e1); kd[r * PK + col] = (bf16)f2bf(kk[i] * __builtin_amdgcn_rcpf(e1)); qe[r * PK + col] = (bf16)f2bf(q * __expf(cum[i])); } }
    LBAR();
    { LAS v4u* dst = (LAS v4u*)(vT + (tid & 127) * 72 + 16 * (tid >> 7)); dst[0] = (v4u){vw[0], vw[1], vw[2], vw[3]}; dst[1] = (v4u){vw[4], vw[5], vw[6], vw[7]}; }
#pragma unroll
    for (int i = 0; i < RC<ISA>::NS; ++i) { const int idx = tid + 512 * i, v = idx / (DK / 8), dc = idx % (DK / 8); *(LAS v4u*)(sT + v * PK + 8 * dc) = sreg[i]; }
    v4u greg[2];
    { const int t = tid >> 3, seg = tid & 7; const bool ok = t < it.nvalid; const bf16* gp = (const bf16*)(a.ws + WS_PROJ) + (size_t)(it.row0 + t) * INP + (ISA ? A_G : C_R) + it.h * 128 + 16 * seg;
      const v4u z4 = {0u, 0u, 0u, 0u}; greg[0] = ok ? *(const v4u*)gp : z4; greg[1] = ok ? *(const v4u*)(gp + 8) : z4; }
    LBAR();
    const int fr = lane & 15, fq = lane >> 4;
    { const int mt = wave >> 1;
#pragma unroll
      for (int n2 = 0; n2 < 2; ++n2) { const int nt = 2 * (wave & 1) + n2; f32x4 acc = {0.f, 0.f, 0.f, 0.f};
          if (nt <= mt) { acc = tile_mma<DK / 32>(acc, kd + (16 * nt + fr) * PK + 8 * fq, qd + (16 * mt + fr) * PK + 8 * fq);
              const int t = 16 * mt + fr, s0 = 16 * nt + 4 * fq;
              if (s0 + 0 > t) acc.x = 0.f; if (s0 + 1 > t) acc.y = 0.f; if (s0 + 2 > t) acc.z = 0.f; if (s0 + 3 > t) acc.w = 0.f; }
          *(LAS v2u*)(att + (16 * mt + fr) * 72 + 16 * nt + 4 * fq) = (v2u){pk2(acc.x, acc.y), pk2(acc.z, acc.w)}; } }
    const int mt2 = wave & 3, ntb = 4 * (wave >> 2);
    f32x4 o[4];
#pragma unroll
    for (int jj = 0; jj < 4; ++jj) o[jj] = tile_mma<DK / 32>((f32x4){0.f, 0.f, 0.f, 0.f}, sT + (16 * (ntb + jj) + fr) * PK + 8 * fq, qe + (16 * mt2 + fr) * PK + 8 * fq);
    LBAR();
#pragma unroll
    for (int jj = 0; jj < 4; ++jj) o[jj] = tile_mma<2>(o[jj], vT + (16 * (ntb + jj) + fr) * 72 + 8 * fq, att + (16 * mt2 + fr) * 72 + 8 * fq);
    LBAR();
    f32x4 nw[4];
#pragma unroll
    for (int i = 0; i < 4; ++i) nw[i] = *(const f32x4*)(a.in[ISA ? 9 : 13] + l * 128 + 16 * (tid & 7) + 4 * i);
#pragma unroll
    for (int jj = 0; jj < 4; ++jj) *(LAS f32x4*)(ofl + (16 * mt2 + fr) * 132 + 16 * (ntb + jj) + 4 * fq) = o[jj];
    LBAR();
    { const int t = tid >> 3, seg = tid & 7; f32x4 x[4]; float ss = 0.f;
#pragma unroll
      for (int i = 0; i < 4; ++i) { x[i] = *(const LAS f32x4*)(ofl + t * 132 + 16 * seg + 4 * i); ss += (x[i].x * x[i].x + x[i].y * x[i].y) + (x[i].z * x[i].z + x[i].w * x[i].w); }
      ss += __shfl_xor(ss, 1); ss += __shfl_xor(ss, 2); ss += __shfl_xor(ss, 4);
      const float rstd = 1.0f / sqrtf(ss * (1.0f / 128.0f) + EPS);
      if (t < it.nvalid) { const size_t row = (size_t)(it.row0 + t);
          const unsigned gw[8] = {greg[0].x, greg[0].y, greg[0].z, greg[0].w, greg[1].x, greg[1].y, greg[1].z, greg[1].w}; unsigned ow[8];
#pragma unroll
          for (int i = 0; i < 4; ++i) { const f32x4 n4 = nw[i];
              const float ga = bflo(gw[2 * i]), gb = bfhi(gw[2 * i]), gc = bflo(gw[2 * i + 1]), gd = bfhi(gw[2 * i + 1]);
              ow[2 * i] = pk2(x[i].x * rstd * n4.x * pg8::silu_f(ga), x[i].y * rstd * n4.y * pg8::silu_f(gb));
              ow[2 * i + 1] = pk2(x[i].z * rstd * n4.z * pg8::silu_f(gc), x[i].w * rstd * n4.w * pg8::silu_f(gd)); }
          bf16* op = (bf16*)(a.ws + WS_MIX) + row * D + (ISA ? MIX_A : MIX_C) + it.h * 128 + 16 * seg;
          *(v4u*)op = (v4u){ow[0], ow[1], ow[2], ow[3]}; *(v4u*)(op + 8) = (v4u){ow[4], ow[5], ow[6], ow[7]}; } }
    LBAR();
}
#define MIX_W(j) do { if (!ISA && !hoist) gla_w_load(W, a, l, seq_item(j).h, tid); } while (0)
template <bool ISA>
__device__ __forceinline__ void pass1_loop(const Args& a, LAS unsigned char* lds, int l, int first, int stride, int tid, int lane, int wave) {
    if (first >= NSLOT) return;
    GlaW W; const bool hoist = (stride & 7) == 0; if (!ISA && hoist) gla_w_load(W, a, l, first & 7, tid);
    MixRegs<ISA> ra, rb; mix_load<ISA, false>(ra, a, l, first, tid);
    for (int j = first;;) {
        if (j + stride < NSLOT) mix_load<ISA, false>(rb, a, l, j + stride, tid);
        MIX_W(j); pass1_compute<ISA>(ra, W, a, lds, j, tid, lane, wave); j += stride; if (j >= NSLOT) break;
        if (j + stride < NSLOT) mix_load<ISA, false>(ra, a, l, j + stride, tid);
        MIX_W(j); pass1_compute<ISA>(rb, W, a, lds, j, tid, lane, wave); j += stride; if (j >= NSLOT) break; }
}
template <bool ISA>
__device__ __forceinline__ void pass3_loop(const Args& a, LAS unsigned char* lds, int l, int first, int stride, int tid, int lane, int wave) {
    if (first >= NSLOT) return;
    GlaW W; const bool hoist = (stride & 7) == 0; if (!ISA && hoist) gla_w_load(W, a, l, first & 7, tid);
    MixRegs<ISA> ra, rb; mix_load<ISA, true>(ra, a, l, first, tid);
    for (int j = first;;) {
        if (j + stride < NSLOT) mix_load<ISA, true>(rb, a, l, j + stride, tid);
        MIX_W(j); pass3_compute<ISA>(ra, W, a, lds, l, j, tid, lane, wave); j += stride; if (j >= NSLOT) break;
        if (j + stride < NSLOT) mix_load<ISA, true>(ra, a, l, j + stride, tid);
        MIX_W(j); pass3_compute<ISA>(rb, W, a, lds, l, j, tid, lane, wave); j += stride; if (j >= NSLOT) break; }
}
template <bool ISA>
__device__ __forceinline__ void scan_vec(const Args& a, int l, int idx) {
    constexpr int DK = RC<ISA>::DK, VPS = 128 * DK / 4;
    const int seq = idx / VPS, e = idx - seq * VPS, v = e / (DK / 4), d4 = (e - v * (DK / 4)) * 4;
    const bf16* __restrict__ U = (const bf16*)(a.ws + (ISA ? WS_UA : WS_UC)); const float* __restrict__ Dv = (const float*)(a.ws + (ISA ? WS_DA : WS_DC));
    bf16* __restrict__ ST = (bf16*)(a.ws + (ISA ? WS_STA : WS_STC));
    if (seq < 32) {
        f32x4 S = {0.f, 0.f, 0.f, 0.f};
#pragma unroll 1
        for (int c0 = 0; c0 < 32; c0 += 8) { f32x4 u[8], dd[8];
#pragma unroll
            for (int j = 0; j < 8; ++j) { const size_t slot = (size_t)seq * 32 + c0 + j; { const v2u uw = *(const v2u*)(U + (slot * 128 + v) * DK + d4); u[j] = (f32x4){bflo(uw.x), bfhi(uw.x), bflo(uw.y), bfhi(uw.y)}; } dd[j] = *(const f32x4*)(Dv + slot * DK + d4); }
#pragma unroll
            for (int j = 0; j < 8; ++j) { const size_t slot = (size_t)seq * 32 + c0 + j; *(v2u*)(ST + (slot * 128 + v) * DK + d4) = (v2u){pk2(S.x, S.y), pk2(S.z, S.w)}; S = dd[j] * S + u[j]; } }
        float* o = a.out + (ISA ? O_SAP : O_SCP) + (((size_t)l * NB * 8 + seq) * DK + d4) * 128 + v;
        o[0] = S.x; o[128] = S.y; o[256] = S.z; o[384] = S.w;
    } else {
        const int ss = seq - 32; const size_t slot = 1024 + ss;
        const float* s0 = a.in[ISA ? 4 : 5] + (((size_t)l * SB * 8 + ss) * DK + d4) * 128 + v;
        const f32x4 S = {s0[0], s0[128], s0[256], s0[384]};
        const v2u uw = *(const v2u*)(U + (slot * 128 + v) * DK + d4); const f32x4 u = {bflo(uw.x), bfhi(uw.x), bflo(uw.y), bfhi(uw.y)}, dd = *(const f32x4*)(Dv + slot * DK + d4);
        *(v2u*)(ST + (slot * 128 + v) * DK + d4) = (v2u){pk2(S.x, S.y), pk2(S.z, S.w)}; const f32x4 F = dd * S + u;
        float* o = a.out + (ISA ? O_SAS : O_SCS) + (((size_t)l * SB * 8 + ss) * DK + d4) * 128 + v;
        o[0] = F.x; o[128] = F.y; o[256] = F.z; o[384] = F.w;
    }
}

template <bool FINAL>
__device__ __forceinline__ void sample_rows_finish(unsigned char* ws, LAS unsigned char* lds, float* ssout, const float* g, float* fout, int tid, int lane, int wave, int bid, int G) {
    LAS float* red = (LAS float*)lds;
    for (int r = bid; r < MS; r += G) { const size_t row = (size_t)MP + r; float s = 0.f; f32x4 x[2];
#pragma unroll
        for (int sg = 0; sg < 2; ++sg) { const int col = (2 * wave + sg) * 256 + 4 * lane; const v2u xb = *(const v2u*)((const bf16*)(ws + WS_XN) + row * D + col);
            x[sg] = (f32x4){bflo(xb.x), bfhi(xb.x), bflo(xb.y), bfhi(xb.y)};
            const float* pp = (const float*)(ws + WS_PART) + (size_t)r * D + col;
#pragma unroll
            for (int ch = 0; ch < 16; ++ch) x[sg] = x[sg] + *(const f32x4*)(pp + (size_t)ch * MS * D);
            s += (x[sg].x * x[sg].x + x[sg].y * x[sg].y) + (x[sg].z * x[sg].z + x[sg].w * x[sg].w); }
        s = wave_sum(s); if (lane == 0) red[wave] = s;
        __syncthreads();
        float t = 0.f;
#pragma unroll
        for (int i = 0; i < NWAVES; ++i) t += red[i];
#pragma unroll
        for (int sg = 0; sg < 2; ++sg) { const int col = (2 * wave + sg) * 256 + 4 * lane;
            if (!FINAL) { v2u w; w.x = pk2(x[sg].x, x[sg].y); w.y = pk2(x[sg].z, x[sg].w); *(v2u*)((bf16*)(ws + WS_XN) + row * D + col) = w; }
            else { const float rstd = 1.0f / sqrtf(t * (1.0f / D) + EPS); *(f32x4*)(fout + row * D + col) = x[sg] * rstd * *(const f32x4*)(g + col); } }
        if (!FINAL && tid == 0) ssout[row] = t;
        __syncthreads(); }
}

__device__ __forceinline__ void ca_item(unsigned char* ws, LAS unsigned char* lds, int l, int rb, int tid, int lane, int wave) {
    const int fr = lane & 15, fq = lane >> 4, row0 = rb * 64;
    const bf16* ap = (const bf16*)(ws + WS_XN) + (size_t)(row0 + fr) * D + wave * 512 + 8 * fq;
    const bf16* bp = (const bf16*)(ws + WS_W1) + (size_t)l * INP * D + ((size_t)(C_A / 128) * (D / 64) + wave * 8) * 8192 + fr * 64 + 8 * fq;
    f32x4 acc[4];
#pragma unroll
    for (int mt = 0; mt < 4; ++mt) acc[mt] = (f32x4){0.f, 0.f, 0.f, 0.f};
#pragma unroll 1
    for (int k0 = 0; k0 < 512; k0 += 128) { bf16x8 av[4][4], bv[4];
#pragma unroll
        for (int ks = 0; ks < 4; ++ks) { bv[ks] = *(const bf16x8*)(bp + (size_t)((k0 + 32 * ks) >> 6) * 8192 + ((k0 + 32 * ks) & 63));
#pragma unroll
            for (int mt = 0; mt < 4; ++mt) av[mt][ks] = *(const bf16x8*)(ap + (size_t)(16 * mt) * D + k0 + 32 * ks); }
#pragma unroll
        for (int ks = 0; ks < 4; ++ks)
#pragma unroll
            for (int mt = 0; mt < 4; ++mt) acc[mt] = __builtin_amdgcn_mfma_f32_16x16x32_bf16(av[mt][ks], bv[ks], acc[mt], 0, 0, 0); }
    LAS f32x4* red = (LAS f32x4*)lds;
#pragma unroll
    for (int mt = 0; mt < 4; ++mt) red[(wave * 4 + mt) * 64 + lane] = acc[mt];
    LBAR();
    if (tid < 256) { const int mt = tid >> 6; f32x4 s = red[mt * 64 + lane];
#pragma unroll
        for (int w = 1; w < 8; ++w) s = s + red[(w * 4 + mt) * 64 + lane];
        const float* ss = (const float*)(ws + WS_SSA);
#pragma unroll
        for (int r = 0; r < 4; ++r) { const int row = row0 + 16 * mt + 4 * fq + r; ((bf16*)(ws + WS_CAB))[(size_t)row * 16 + fr] = (bf16)f2bf(s[r] * pg8::rstd_of(ss[row])); } }
    LBAR();
}

constexpr int PH_PER_LAYER = 10, NPHASE = 1 + PH_PER_LAYER * DEPTH;
__global__ void __launch_bounds__(NWAVES * 64, 2) hymba_fwd(Args a) {
    extern __shared__ __attribute__((aligned(16))) unsigned char lds_raw[];
    LAS unsigned char* lds = (LAS unsigned char*)lds_raw;
    const int G = gridDim.x, bid = blockIdx.x;
    unsigned char* const ws0 = a.ws;
    for (int u = threadIdx.x; u < (LDS_BYTES - RING_BYTES) / 4; u += NWAVES * 64) ((LAS unsigned*)(lds + RING_BYTES))[u] = 0u;
    __syncthreads();
    const int lo = a.ph_lo, hi = a.ph_hi;
    const bool use_vc = (lo == 0 && hi - lo > 1 && (G & 7) == 0);
    if (use_vc && threadIdx.x == 0) { const unsigned x = xb_xcc_id() & 7u; const unsigned r = xb_add((unsigned*)(ws0 + WS_CTL) + CW_RANK + 64 * x, 1u);
        if (r >= (unsigned)(G / 8)) (void)xb_add((unsigned*)(ws0 + WS_CTL) + CW_FALL, 1u);
        ((volatile LAS unsigned*)(lds + MISC_OFF))[16] = r * 8u + x; }
    XcdBarrier bar; bar.bar = (unsigned*)(ws0 + WS_CTL) + CW_BAR; bar.x = 0; bar.st = nullptr;
    if (hi - lo > 1) bar = xcd_barrier_post((unsigned*)(ws0 + WS_CTL) + CW_BAR, (volatile LAS unsigned*)(lds + MISC_OFF) + 8);
#define IN(k) (lo <= (k) && (k) < hi)
#define WSL() GAS unsigned char* ws_g = (GAS unsigned char*)ws0; asm volatile("" : "+s"(ws_g)); unsigned char* ws = (unsigned char*)ws_g
#define LAUNDER() WSL(); (void)ws; int tid = threadIdx.x; asm volatile("" : "+v"(tid)); const int lane = tid & 63, wave = __builtin_amdgcn_readfirstlane(tid >> 6); (void)lane; (void)wave
#define SEAM(k) do { if ((k) + 1 < hi) xcd_barrier(bar); } while (0)

    if (IN(0)) { LAUNDER(); prologue(a, lds, tid, lane, wave, bid, G); SEAM(0); }
    int vc = bid;
    if (use_vc) { const unsigned fall = xb_ld((unsigned*)(ws0 + WS_CTL) + CW_FALL); const unsigned v = ((volatile LAS unsigned*)(lds + MISC_OFF))[16]; if (fall == 0u && v < (unsigned)G) vc = (int)v; }
    vc = __builtin_amdgcn_readfirstlane(vc);

#pragma unroll 1
    for (int l = 0; l < DEPTH; ++l) {
        const int pb = 1 + PH_PER_LAYER * l;
        if (IN(pb + 0)) { WSL();
            constexpr int NG1 = C_A;
            pg8::Gemm g{(const pg8::bf16_t*)(ws + WS_XN), (const pg8::bf16_t*)(ws + WS_W1) + (size_t)l * INP * D, MP, NG1, D};
            { pg8::StaticOrder S; S.init(MP, NG1, D, G, vc); S.WGM = 8; pg8::EpiProj<2> E{(pg8::bf16_t*)(ws + WS_PROJ), INP, (const float*)(ws + WS_SSA)};
              pg8::gemm_phase<pg8::EpiProj<2>, pg8::StaticOrder, true, true, false>(lds, g, S, E); }
            const int rem = ((MP / 256) * (NG1 / 256)) % G, nfree = G - rem, fidx = vc >= rem ? vc - rem : -1;
            { pg8::PanelOrder S{MP / 256, NG1 / 256, 1, D / 64, fidx, nfree, NG1 / 256}; pg8::EpiProj<1> E{(pg8::bf16_t*)(ws + WS_PROJ), INP, (const float*)(ws + WS_SSA)};
              pg8::gemm_phase<pg8::EpiProj<1>, pg8::PanelOrder, true, true, true>(lds, g, S, E); }
            { int tid = threadIdx.x; asm volatile("" : "+v"(tid)); const int lane = tid & 63, wave = __builtin_amdgcn_readfirstlane(tid >> 6);
              const int nsamp = NG1 / 256, ncaw = nfree > nsamp ? nfree - nsamp : nfree, cfirst = nfree > nsamp ? fidx - nsamp : fidx;
              if (fidx >= 0 && cfirst >= 0) for (int rb = cfirst; rb < MV / 64; rb += ncaw) ca_item(ws, lds, l, rb, tid, lane, wave); }
            SEAM(pb + 0);
        }
        if (IN(pb + 1)) { LAUNDER();
            constexpr int NSWA = 512 + 32;
            for (int it = bid; it < 512; it += G) swa_prompt_item(a, lds, l, it, tid, lane, wave);
            for (int it = 512 + ((bid + G - 64) % G); it < NSWA; it += G) swa_item(a, lds, l, it, tid, lane, wave);
            pass1_loop<true>(a, lds, l, bid, G, tid, lane, wave);
            pass1_loop<false>(a, lds, l, (G & 7) == 0 && G >= 256 ? (bid + G - 128) % G : bid, G, tid, lane, wave);
            SEAM(pb + 1);
        }
        if (IN(pb + 2)) { LAUNDER();
            const int gt = bid * 512 + tid, NT = G * 512;
            constexpr int NA = 96 * 128 * 128 / 4, NC = 96 * 128 * 64 / 4;
            for (int i = gt; i < NA; i += NT) scan_vec<true>(a, l, i);
            for (int i = gt; i < NC; i += NT) scan_vec<false>(a, l, i);
            SEAM(pb + 2);
        }
        if (IN(pb + 3)) { LAUNDER();
            pass3_loop<true>(a, lds, l, bid, G, tid, lane, wave);
            pass3_loop<false>(a, lds, l, (G & 7) == 0 && G >= 256 ? (bid + G - 128) % G : bid, G, tid, lane, wave);
            SEAM(pb + 3);
        }
        if (IN(pb + 4)) { WSL();
            pg8::Gemm g{(const pg8::bf16_t*)(ws + WS_MIX), (const pg8::bf16_t*)(ws + WS_W2) + (size_t)l * D * D, MP, D, D};
            { pg8::StaticOrder S; S.init(MP, D, D, G, vc); pg8::EpiResidN E{(pg8::bf16_t*)(ws + WS_XN), (float*)(ws + WS_SSP), D};
              pg8::gemm_phase<pg8::EpiResidN, pg8::StaticOrder, true, true, false>(lds, g, S, E); }
            { pg8::PanelOrder S{MP / 256, D / 256, 16, D / 64, bid, G, 16 * (D / 256)}; pg8::EpiPartial E{(float*)(ws + WS_PART), D};
              pg8::gemm_phase<pg8::EpiPartial, pg8::PanelOrder, true, true, true>(lds, g, S, E); }
            SEAM(pb + 4);
        }
        if (IN(pb + 5)) { LAUNDER();
            const int gw = bid * NWAVES + wave, NGW = G * NWAVES;
            for (int i = bid * 512 + tid; i < MP * 16; i += G * 512) { const int row = i >> 4, q = i & 15; const f32x4 pv = *(const f32x4*)((const float*)(ws + WS_SSP) + (size_t)row * 64 + 4 * q);
                float s = (pv.x + pv.y) + (pv.z + pv.w); s += __shfl_xor(s, 1); s += __shfl_xor(s, 2); s += __shfl_xor(s, 4); s += __shfl_xor(s, 8); if (q == 0) ((float*)(ws + WS_SSB))[row] = s; }
            sample_rows_finish<false>(ws, lds, (float*)(ws + WS_SSB), nullptr, nullptr, tid, lane, wave, bid, G);
            SEAM(pb + 5);
        }
        if (IN(pb + 6)) { WSL();
            pg8::Gemm g{(const pg8::bf16_t*)(ws + WS_XN), (const pg8::bf16_t*)(ws + WS_W3) + (size_t)l * 2 * DFF * D, MP, 2 * DFF, D};
            { pg8::StaticOrder S; S.init(MP, 2 * DFF, D, G, vc); S.WGM = 4; pg8::EpiSwiGLU<2> E{(pg8::bf16_t*)(ws + WS_ACT), DFF, (const float*)(ws + WS_SSB)};
              pg8::gemm_phase<pg8::EpiSwiGLU<2>, pg8::StaticOrder, true, true, false>(lds, g, S, E); }
            { const int rem = ((MP / 256) * (2 * DFF / 256)) % G; pg8::TriOrder S{MP / 256, 2 * DFF / 128, D / 64, vc >= rem ? vc - rem : -1, G - rem};
              pg8::EpiGU E{(float*)(ws + WS_GU), 2 * DFF, (const float*)(ws + WS_SSB) + MP};
              pg8::gemm_phase<pg8::EpiGU, pg8::TriOrder, true, true, 2>(lds, g, S, E); }
            SEAM(pb + 6);
        }
        if (IN(pb + 7)) { LAUNDER();
            const float* GU = (const float*)(ws + WS_GU); bf16* ACT = (bf16*)(ws + WS_ACT) + (size_t)MP * DFF;
            for (int idx = bid * 512 + tid; idx < MS * (DFF / 4); idx += G * 512) { const int r = idx / (DFF / 4), j4 = (idx - r * (DFF / 4)) * 4, t = j4 >> 7, i = j4 & 127;
                const f32x4 gg = *(const f32x4*)(GU + (size_t)r * 2 * DFF + 256 * t + i), uu = *(const f32x4*)(GU + (size_t)r * 2 * DFF + 256 * t + 128 + i);
                *(v2u*)(ACT + (size_t)r * DFF + j4) = (v2u){pk2(pg8::silu_f(gg.x) * uu.x, pg8::silu_f(gg.y) * uu.y), pk2(pg8::silu_f(gg.z) * uu.z, pg8::silu_f(gg.w) * uu.w)}; }
            SEAM(pb + 7);
        }
        if (IN(pb + 8)) { WSL();
            pg8::Gemm g{(const pg8::bf16_t*)(ws + WS_ACT), (const pg8::bf16_t*)(ws + WS_W4) + (size_t)l * D * DFF, MP, D, DFF};
            { pg8::StaticOrder S; S.init(MP, D, DFF, G, vc); pg8::EpiResidN E{(pg8::bf16_t*)(ws + WS_XN), (float*)(ws + WS_SSP), D};
              pg8::gemm_phase<pg8::EpiResidN, pg8::StaticOrder, true, true, false>(lds, g, S, E); }
            { pg8::PanelOrder S{MP / 256, D / 256, 16, DFF / 64, bid, G, 16 * (D / 256)}; pg8::EpiPartial E{(float*)(ws + WS_PART), D};
              pg8::gemm_phase<pg8::EpiPartial, pg8::PanelOrder, true, true, true>(lds, g, S, E); }
            SEAM(pb + 8);
        }
        if (IN(pb + 9)) { LAUNDER();
            const int gw = bid * NWAVES + wave, NGW = G * NWAVES;
            if (l + 1 < DEPTH) {
                for (int i = bid * 512 + tid; i < MP * 16; i += G * 512) { const int row = i >> 4, q = i & 15; const f32x4 pv = *(const f32x4*)((const float*)(ws + WS_SSP) + (size_t)row * 64 + 4 * q);
                float s = (pv.x + pv.y) + (pv.z + pv.w); s += __shfl_xor(s, 1); s += __shfl_xor(s, 2); s += __shfl_xor(s, 4); s += __shfl_xor(s, 8); if (q == 0) ((float*)(ws + WS_SSA))[row] = s; }
                sample_rows_finish<false>(ws, lds, (float*)(ws + WS_SSA), nullptr, nullptr, tid, lane, wave, bid, G);
            } else { sample_rows_finish<true>(ws, lds, nullptr, a.in[18], a.out + O_YP, tid, lane, wave, bid, G); for (int m = gw; m < MP; m += 2 * NGW) final_rows2((const bf16*)(ws + WS_XN), a.in[18], a.out + O_YP, m, m + NGW < MP ? m + NGW : m, lane); }
            SEAM(pb + 9);
        }
    }
#undef IN
#undef SEAM
}

#ifndef MK_PER_PHASE
#define MK_PER_PHASE 0
#endif
extern "C" void kernel_launch(void* const* d_in, const int* in_sizes, int n_in, void* d_out, int out_size, void* d_ws, size_t ws_size, hipStream_t stream) {
    static int grid = 0;
    if (grid == 0) {
        if (n_in != 19 || (size_t)out_size != O_END || ws_size < WS_END) { fprintf(stderr, "kernel_launch: unexpected shapes (n_in %d, out %d, ws %zu need %zu)\n", n_in, out_size, ws_size, (size_t)WS_END); grid = -1; return; }
        int dev = 0, cus = 0, per_cu = 0;
        if (hipGetDevice(&dev) != hipSuccess || hipDeviceGetAttribute(&cus, hipDeviceAttributeMultiprocessorCount, dev) != hipSuccess) { grid = -1; return; }
        if (hipFuncSetAttribute((const void*)hymba_fwd, hipFuncAttributeMaxDynamicSharedMemorySize, LDS_BYTES) != hipSuccess) { fprintf(stderr, "kernel_launch: hipFuncSetAttribute failed\n"); grid = -1; return; }
        if (hipOccupancyMaxActiveBlocksPerMultiprocessor(&per_cu, (const void*)hymba_fwd, NWAVES * 64, LDS_BYTES) != hipSuccess || per_cu < 1) { fprintf(stderr, "kernel_launch: occupancy query says %d\n", per_cu); }
        (void)hipGetLastError();
        grid = cus;
    }
    if (grid < 0) return;
    (void)hipMemsetAsync((char*)d_ws + WS_CTL, 0, CTL_BYTES, stream);
    Args a{};
    for (int i = 0; i < 19; ++i) a.in[i] = (const float*)d_in[i];
    a.out = (float*)d_out; a.ws = (unsigned char*)d_ws;
#if MK_PER_PHASE
    for (int p = 0; p < NPHASE; ++p) { a.ph_lo = p; a.ph_hi = p + 1; hipLaunchKernelGGL(hymba_fwd, dim3(grid), dim3(NWAVES * 64), LDS_BYTES, stream, a); }
#else
    a.ph_lo = 0; a.ph_hi = NPHASE; hipLaunchKernelGGL(hymba_fwd, dim3(grid), dim3(NWAVES * 64), LDS_BYTES, stream, a);
#endif
}
```

```cpp
#include <hip/hip_runtime.h>
#include <cstdio>
#include <cstdint>
namespace pg8 {
#define PG8_LAS __attribute__((address_space(3)))
typedef unsigned short bf16_t;
typedef short bf16x8 __attribute__((ext_vector_type(8)));
typedef float f32x4 __attribute__((ext_vector_type(4)));
typedef unsigned u32x4 __attribute__((ext_vector_type(4)));
constexpr int BM = 256, BK = 64, HALF = 128, HTB = HALF * BK * 2  , STAGE_BYTES = 8 * HTB, NXCD = 8;

__host__ __device__ __forceinline__ int lds_byte(int r, int c) { const int st = (r >> 4) * 2 + (c >> 5), rr = r & 15, cc = c & 31, ob = rr * 64 + cc * 2; return st * 1024 + (ob ^ (((ob >> 9) & 1) << 5)); }
__host__ __device__ __forceinline__ void stage_rc(int b, int& R, int& C) { const int st = b / 1024, sb = b % 1024, swz = sb ^ (((sb >> 9) & 1) << 5); R = (st >> 1) * 16 + swz / 64; C = (st & 1) * 32 + (swz % 64) / 2; }
__host__ __device__ __forceinline__ int perm32(int rho) { const int n = rho >> 4, i = rho & 15; return 8 * (i >> 2) + 4 * n + (i & 3); }

struct Unit { int pm, pn, kb, nt, ch, brow; };
struct Gemm { const bf16_t* A; const bf16_t* Bt; int M, N, K; };

struct StaticOrder {
    int nM, nN, nwg, G, c, ntk, WGM = 8;
    __host__ __device__ void init(int M, int N, int K, int G_, int c_) { nM = M / BM; nN = N / BM; nwg = nM * nN; G = G_; c = c_; ntk = K / BK; }
    __host__ __device__ bool next(int i, Unit& u) const {
        const long L = (long)i * G + c; if (L >= nwg) return false;
        int wgid = (int)L; { const int q = nwg / NXCD, r = nwg % NXCD, xcd = wgid % NXCD, off = wgid / NXCD; wgid = (xcd < r ? xcd * (q + 1) : r * (q + 1) + (xcd - r) * q) + off; }
        const int nig = WGM * nN, gid = wgid / nig, fm = gid * WGM, gsz = (nM - fm) < WGM ? (nM - fm) : WGM;
        u.pm = fm + ((wgid % nig) % gsz); u.pn = (wgid % nig) / gsz; u.kb = 0; u.nt = ntk; u.ch = 0; u.brow = 2 * u.pn; return true;
    }
    __device__ __forceinline__ void a_ready(const Unit&) const {}
    __device__ __forceinline__ void done(const Unit&) const {}
};
struct PanelOrder {
    int pm, nN, nchunk, ntk, first, stride, count;
    __host__ __device__ bool next(int i, Unit& u) const {
        if (first < 0) return false; const int j = first + i * stride; if (j >= count) return false;
        u.pm = pm; u.pn = j % nN; const int ch = j / nN, pairs = ntk / 2, p0 = pairs * ch / nchunk, p1 = pairs * (ch + 1) / nchunk; u.kb = 2 * p0; u.nt = 2 * (p1 - p0); u.ch = ch; u.brow = 2 * u.pn; return true;
    }
    __device__ __forceinline__ void a_ready(const Unit&) const {}
    __device__ __forceinline__ void done(const Unit&) const {}
};
struct TriOrder {
    int pm, nhalf, ntk, first, stride;
    __host__ __device__ bool next(int i, Unit& u) const {
        const int count = (nhalf + 2) / 3; if (first < 0) return false; const int j = first + i * stride; if (j >= count) return false;
        u.pm = pm; u.pn = j; u.kb = 0; u.nt = ntk; u.ch = 0; u.brow = (3 * j + 3 <= nhalf) ? 3 * j : nhalf - 3; return true;
    }
    __device__ __forceinline__ void a_ready(const Unit&) const {}
    __device__ __forceinline__ void done(const Unit&) const {}
};

__device__ __forceinline__ unsigned cvt_pk_bf16(float lo, float hi) { unsigned r; asm volatile("v_cvt_pk_bf16_f32 %0, %1, %2" : "=v"(r) : "v"(lo), "v"(hi)); return r; }
__device__ __forceinline__ float silu_f(float g) { return g * __builtin_amdgcn_rcpf(1.0f + __expf(-g)); }
__device__ __forceinline__ float rstd_of(float ss) { return __builtin_amdgcn_rsqf(ss * (1.0f / 4096.0f) + 1e-6f); }
template <int NAI> struct EpiProj {
    static constexpr bool PERM = true, AFTER_DRAIN = false, SS_LDS = true;
    bf16_t* O; int ldc; const float* ss;
    __device__ __forceinline__ void with_lds(const f32x4 (&acc)[2][2][4][2], const Unit& u, int wr, int wc, int fr, int fq, const PG8_LAS float* sl) const {
        const int row0 = u.pm * BM + wr * 64 + fr, col0 = u.pn * BM + wc * 32 + 8 * fq;
        float rs[NAI][4];
#pragma unroll
        for (int ai = 0; ai < NAI; ++ai)
#pragma unroll
            for (int m = 0; m < 4; ++m) rs[ai][m] = rstd_of(sl[wr * 64 + fr + ai * HALF + m * 16]);
#pragma unroll
        for (int ai = 0; ai < NAI; ++ai)
#pragma unroll
            for (int m = 0; m < 4; ++m) { bf16_t* rowp = O + (size_t)(row0 + ai * HALF + m * 16) * ldc + col0; const float r = rs[ai][m];
#pragma unroll
                for (int bj = 0; bj < 2; ++bj) { const f32x4 v0 = acc[ai][bj][m][0] * r, v1 = acc[ai][bj][m][1] * r;
                    u32x4 w; w.x = cvt_pk_bf16(v0[0], v0[1]); w.y = cvt_pk_bf16(v0[2], v0[3]); w.z = cvt_pk_bf16(v1[0], v1[1]); w.w = cvt_pk_bf16(v1[2], v1[3]);
                    *(u32x4*)(rowp + bj * HALF) = w; } }
    }
};
template <int NAI> struct EpiSwiGLU {
    static constexpr bool PERM = true, AFTER_DRAIN = false, SS_LDS = true;
    bf16_t* O; int ldc; const float* ss;
    __device__ __forceinline__ void with_lds(const f32x4 (&acc)[2][2][4][2], const Unit& u, int wr, int wc, int fr, int fq, const PG8_LAS float* sl) const {
        const int row0 = u.pm * BM + wr * 64 + fr, col0 = u.pn * HALF + wc * 32 + 8 * fq;
        float rs[NAI][4];
#pragma unroll
        for (int ai = 0; ai < NAI; ++ai)
#pragma unroll
            for (int m = 0; m < 4; ++m) rs[ai][m] = rstd_of(sl[wr * 64 + fr + ai * HALF + m * 16]);
#pragma unroll
        for (int ai = 0; ai < NAI; ++ai)
#pragma unroll
            for (int m = 0; m < 4; ++m) { bf16_t* rowp = O + (size_t)(row0 + ai * HALF + m * 16) * ldc + col0; const float r = rs[ai][m];
                const f32x4 g0 = acc[ai][0][m][0] * r, g1 = acc[ai][0][m][1] * r, u0 = acc[ai][1][m][0] * r, u1 = acc[ai][1][m][1] * r;
                u32x4 w; w.x = cvt_pk_bf16(silu_f(g0[0]) * u0[0], silu_f(g0[1]) * u0[1]); w.y = cvt_pk_bf16(silu_f(g0[2]) * u0[2], silu_f(g0[3]) * u0[3]);
                w.z = cvt_pk_bf16(silu_f(g1[0]) * u1[0], silu_f(g1[1]) * u1[1]); w.w = cvt_pk_bf16(silu_f(g1[2]) * u1[2], silu_f(g1[3]) * u1[3]);
                *(u32x4*)rowp = w; }
    }
};
struct EpiResidN {
    static constexpr bool PERM = true, AFTER_DRAIN = false, SS_LDS = false;
    bf16_t* XB; float* ssp; int ldc;
    __device__ __forceinline__ void operator()(const f32x4 (&acc)[2][2][4][2], const Unit& u, int wr, int wc, int fr, int fq) const {
        const int row0 = u.pm * BM + wr * 64 + fr, col0 = u.pn * BM + wc * 32 + 8 * fq;
        u32x4 xr[2][4][2];
#pragma unroll
        for (int ai = 0; ai < 2; ++ai)
#pragma unroll
            for (int m = 0; m < 4; ++m)
#pragma unroll
                for (int bj = 0; bj < 2; ++bj) xr[ai][m][bj] = *(const u32x4*)(XB + (size_t)(row0 + ai * HALF + m * 16) * ldc + col0 + bj * HALF);
#pragma unroll
        for (int ai = 0; ai < 2; ++ai)
#pragma unroll
            for (int m = 0; m < 4; ++m) { const int row = row0 + ai * HALF + m * 16; bf16_t* bp = XB + (size_t)row * ldc + col0; float s = 0.f;
#pragma unroll
                for (int bj = 0; bj < 2; ++bj) { const u32x4 r = xr[ai][m][bj]; const unsigned rw[4] = {r.x, r.y, r.z, r.w}; float v[8];
#pragma unroll
                    for (int j = 0; j < 4; ++j) { v[2 * j] = __builtin_bit_cast(float, rw[j] << 16) + acc[ai][bj][m][j >> 1][(2 * j) & 3]; v[2 * j + 1] = __builtin_bit_cast(float, rw[j] & 0xffff0000u) + acc[ai][bj][m][j >> 1][(2 * j + 1) & 3]; }
#pragma unroll
                    for (int j = 0; j < 8; ++j) s += v[j] * v[j];
                    u32x4 w; w.x = cvt_pk_bf16(v[0], v[1]); w.y = cvt_pk_bf16(v[2], v[3]); w.z = cvt_pk_bf16(v[4], v[5]); w.w = cvt_pk_bf16(v[6], v[7]);
                    *(u32x4*)(bp + bj * HALF) = w; }
                s += __shfl_xor(s, 16); s += __shfl_xor(s, 32);
                if (fq == 0) ssp[(size_t)row * 64 + u.pn * 4 + wc] = s; }
    }
};
struct EpiPartial {
    static constexpr bool PERM = true, AFTER_DRAIN = false, SS_LDS = false;
    float* P; int ldc;
    __device__ __forceinline__ void operator()(const f32x4 (&acc)[2][2][4][2], const Unit& u, int wr, int wc, int fr, int fq) const {
        const int row0 = wr * 64 + fr, col0 = u.pn * BM + wc * 32 + 8 * fq;
#pragma unroll
        for (int m = 0; m < 4; ++m) { float* rowp = P + ((size_t)u.ch * HALF + row0 + m * 16) * ldc + col0;
#pragma unroll
            for (int bj = 0; bj < 2; ++bj)
#pragma unroll
                for (int n = 0; n < 2; ++n) *(f32x4*)(rowp + bj * HALF + n * 4) = acc[0][bj][m][n]; }
    }
};
struct EpiGU {
    static constexpr bool PERM = true, AFTER_DRAIN = false, SS_LDS = false;
    float* GU; int ldc; const float* ss;
    __device__ __forceinline__ void operator()(const f32x4 (&acc)[2][2][4][2], const Unit& u, int wr, int wc, int fr, int fq) const {
        const int row0 = wr * 64 + fr, col0 = u.brow * HALF + wc * 32 + 8 * fq;
#pragma unroll
        for (int m = 0; m < 4; ++m) { const int row = row0 + m * 16; const float r = rstd_of(ss[row]); float* rowp = GU + (size_t)row * ldc + col0;
#pragma unroll
            for (int n = 0; n < 2; ++n) { *(f32x4*)(rowp + n * 4) = acc[0][0][m][n] * r; *(f32x4*)(rowp + HALF + n * 4) = acc[0][1][m][n] * r; *(f32x4*)(rowp + 2 * HALF + n * 4) = acc[1][0][m][n] * r; } }
    }
};

template <class Epi, class Sched, bool ALIGN_EPI = false, bool SP2 = false, int MODE = 0>
__device__ __forceinline__ void gemm_phase(PG8_LAS unsigned char* lds, const Gemm g, const Sched& S, const Epi& E) {
    int tid_l = threadIdx.x; asm volatile("" : "+v"(tid_l));
    const int tid = tid_l, wid = __builtin_amdgcn_readfirstlane(tid >> 6), lane = tid & 63, wr = wid >> 2, wc = wid & 3, fr = lane & 15, fq = lane >> 4;
    const int K = g.K; constexpr bool HALF_M = MODE != 0; (void)HALF_M; static_assert(MODE != 2 || SP2, "tri units need the SP2 loop");
    unsigned voffA[2], voffB[2];
#pragma unroll
    for (int i = 0; i < 2; ++i) { int R, C; stage_rc(tid * 16 + i * 8192, R, C); const int Rb = Epi::PERM ? ((R & ~31) + perm32(R & 31)) : R;
        voffA[i] = (unsigned)(R * K + C) * 2u; voffB[i] = (unsigned)(Rb * BK + C) * 2u; }
    const size_t kstep = (size_t)(BK * 2);
    const size_t kstepB = (size_t)HTB;
    const size_t hstep = (size_t)HALF * K * 2;
    const size_t tstep = 2 * hstep;
    const unsigned ldsu = (unsigned)(__UINTPTR_TYPE__)lds;
    const unsigned ldsw = (unsigned)wid * 1024u;
    constexpr int PG8_SS_OFF = STAGE_BYTES + 8192;
    const int aoff = lds_byte(wr * 64 + fr, fq * 8), boff = lds_byte(wc * 32 + fr, fq * 8);
    int boffB_l = boff + 4 * HTB; asm volatile("" : "+v"(boffB_l)); const int boffB = boffB_l;
#define PG8_SA(b, h) (((b) * 2 + (h)) * HTB)
#define PG8_SB(b, h) ((4 + (b) * 2 + (h)) * HTB)
#define PG8_STAGE(bufoff, gbase, voff) do { _Pragma("unroll") for (int _i = 0; _i < 2; ++_i) \
        asm volatile("s_mov_b32 m0, %2\n\ts_nop 0\n\tglobal_load_lds_dwordx4 %0, %1" ::"v"((voff)[_i]), "s"((const char*)(gbase)), "s"(ldsu + (unsigned)(bufoff) + ldsw + (unsigned)(_i * 8192)) : "memory"); } while (0)
#define PG8_LDA(dst, b, h) do { _Pragma("unroll") for (int m = 0; m < 4; ++m) _Pragma("unroll") for (int k = 0; k < 2; ++k) dst[m][k] = *(const PG8_LAS bf16x8*)(lds + PG8_SA(b, h) + aoff + m * 2048 + k * 1024); } while (0)
#define PG8_LDB(dst, b, h) do { _Pragma("unroll") for (int n = 0; n < 2; ++n) _Pragma("unroll") for (int k = 0; k < 2; ++k) dst[n][k] = *(const PG8_LAS bf16x8*)(lds + boffB + ((b) * 2 + (h)) * HTB + n * 2048 + k * 1024); } while (0)
#define PG8_MMA0(ai, bj, At, Bt) do { _Pragma("unroll") for (int m = 0; m < 4; ++m) _Pragma("unroll") for (int n = 0; n < 2; ++n) _Pragma("unroll") for (int k = 0; k < 2; ++k) \
        acc[ai][bj][m][n] = __builtin_amdgcn_mfma_f32_16x16x32_bf16(Bt[n][k], At[m][k], acc[ai][bj][m][n], 0, 0, 0); } while (0)
#define PG8_MMA(ai, bj, At, Bt) do { __builtin_amdgcn_s_setprio(1); PG8_MMA0(ai, bj, At, Bt); __builtin_amdgcn_s_setprio(0); } while (0)
#define PG8_PRIO1 __builtin_amdgcn_s_setprio(1)
#define PG8_PRIO0 __builtin_amdgcn_s_setprio(0)
#define PG8_WAIT_L0B __builtin_amdgcn_s_waitcnt(0xC07F)
#define PG8_WAIT_VL __builtin_amdgcn_s_waitcnt(0x0078)
#define PG8_STAGE_A1(bufoff, aptr, bptr) do { if constexpr (MODE == 2) PG8_STAGE(bufoff, (bptr) + 2 * hstep, voffB); else PG8_STAGE(bufoff, (aptr) + hstep, voffA); } while (0)
#define PG8_LDB2(dst, b) do { _Pragma("unroll") for (int n = 0; n < 2; ++n) _Pragma("unroll") for (int k = 0; k < 2; ++k) dst[n][k] = *(const PG8_LAS bf16x8*)(lds + PG8_SA(b, 1) + boff + n * 2048 + k * 1024); } while (0)
#define PG8_WAIT_V(n) asm volatile("s_waitcnt vmcnt(" #n ")" ::: "memory")
#define PG8_WAIT_L(n) asm volatile("s_waitcnt lgkmcnt(" #n ")" ::: "memory")
#define PG8_BAR __builtin_amdgcn_s_barrier()
#define PG8_SCHED __builtin_amdgcn_sched_barrier(0)
    Unit cur, nxt; int ui = 0, sslot = 0; (void)sslot;
    if (!S.next(0, cur)) return;
    f32x4 acc[2][2][4][2];
#pragma unroll
    for (int a = 0; a < 2; ++a)
#pragma unroll
        for (int b = 0; b < 2; ++b)
#pragma unroll
            for (int m = 0; m < 4; ++m)
#pragma unroll
                for (int n = 0; n < 2; ++n) acc[a][b][m][n] = (f32x4){0.f, 0.f, 0.f, 0.f};
    bf16x8 At[4][2], B0[2][2], B1[2][2];
    const char* cA = (const char*)g.A + (size_t)cur.pm * tstep + (size_t)cur.kb * kstep; const char* cB = (const char*)g.Bt + (size_t)cur.brow * hstep + (size_t)cur.kb * kstepB;
    if constexpr (Epi::SS_LDS) { if (wid == 0) asm volatile("s_mov_b32 m0, %2\n\ts_nop 0\n\tglobal_load_lds_dwordx4 %0, %1" ::"v"((unsigned)lane * 16u), "s"((const char*)(E.ss + (size_t)cur.pm * BM)), "s"(ldsu + (unsigned)PG8_SS_OFF) : "memory"); }
    S.a_ready(cur);
    if constexpr (SP2) {
        PG8_STAGE(PG8_SB(0, 0), cB, voffB); PG8_STAGE(PG8_SB(0, 1), cB + hstep, voffB); PG8_STAGE(PG8_SA(0, 0), cA, voffA); PG8_STAGE_A1(PG8_SA(0, 1), cA, cB);
        if (wr == 1) PG8_BAR;
        PG8_WAIT_V(2); PG8_BAR;
        PG8_STAGE(PG8_SB(1, 0), cB + kstepB, voffB); PG8_STAGE(PG8_SA(1, 0), cA + kstep, voffA); PG8_STAGE(PG8_SB(1, 1), cB + hstep + kstepB, voffB);
        PG8_WAIT_V(6); PG8_BAR;
    } else {
        PG8_STAGE(PG8_SB(0, 0), cB, voffB); PG8_STAGE(PG8_SA(0, 0), cA, voffA); PG8_STAGE(PG8_SB(0, 1), cB + hstep, voffB); PG8_STAGE(PG8_SA(0, 1), cA + hstep, voffA);
        if (wr == 1) PG8_BAR;
        PG8_WAIT_V(4); PG8_BAR;
        PG8_STAGE(PG8_SB(1, 0), cB + kstepB, voffB); PG8_STAGE(PG8_SA(1, 0), cA + kstep, voffA); PG8_STAGE(PG8_SB(1, 1), cB + hstep + kstepB, voffB);
        PG8_WAIT_V(6); PG8_BAR;
    }
    for (;;) {
        const bool has_next = S.next(ui + 1, nxt);
        if constexpr (Epi::SS_LDS) { if (has_next && wid == 0) asm volatile("s_mov_b32 m0, %2\n\ts_nop 0\n\tglobal_load_lds_dwordx4 %0, %1" ::"v"((unsigned)lane * 16u), "s"((const char*)(E.ss + (size_t)nxt.pm * BM)), "s"(ldsu + (unsigned)PG8_SS_OFF + (unsigned)((sslot == 2 ? 0 : sslot + 1) * 1024)) : "memory"); }
        const char* nA = has_next ? (const char*)g.A + (size_t)nxt.pm * tstep + (size_t)nxt.kb * kstep : cA; const char* nB = has_next ? (const char*)g.Bt + (size_t)nxt.brow * hstep + (size_t)nxt.kb * kstepB : cB;
        const int nt = cur.nt;
        for (int t = 0; t < nt; t += 2) {
            const bool last = (t == nt - 2);
            const char* a1 = cA + (size_t)(t + 1) * kstep;
            const char* a2 = last ? nA : cA + (size_t)(t + 2) * kstep; const char* b2 = last ? nB : cB + (size_t)(t + 2) * kstepB;
            const char* a3 = a2 + kstep; const char* b3 = b2 + kstepB;
            if (last && has_next) S.a_ready(nxt);
            if constexpr (SP2) {
            PG8_LDB(B0, 0, 0); PG8_LDB(B1, 0, 1); PG8_SCHED; PG8_LDA(At, 0, 0); PG8_STAGE_A1(PG8_SA(1, 1), a1, cB + (size_t)(t + 1) * kstepB);
            PG8_WAIT_VL; PG8_PRIO1; PG8_BAR; PG8_SCHED; PG8_MMA0(0, 0, At, B0); PG8_MMA0(0, 1, At, B1); PG8_SCHED; PG8_BAR; PG8_PRIO0; PG8_SCHED;
            if constexpr (MODE == 0) PG8_LDA(At, 0, 1); if constexpr (MODE == 2) PG8_LDB2(B0, 0); PG8_STAGE(PG8_SB(0, 0), b2, voffB); PG8_STAGE(PG8_SB(0, 1), b2 + hstep, voffB); PG8_STAGE(PG8_SA(0, 0), a2, voffA);
            PG8_WAIT_VL; PG8_PRIO1; PG8_BAR; PG8_SCHED; if constexpr (MODE == 0) { PG8_MMA0(1, 0, At, B0); PG8_MMA0(1, 1, At, B1); } if constexpr (MODE == 2) { PG8_MMA0(1, 0, At, B0); } PG8_SCHED; PG8_BAR; PG8_PRIO0; PG8_SCHED;
            PG8_LDB(B0, 1, 0); PG8_LDB(B1, 1, 1); PG8_SCHED; PG8_LDA(At, 1, 0); PG8_STAGE_A1(PG8_SA(0, 1), a2, b2);
            PG8_WAIT_VL; PG8_PRIO1; PG8_BAR; PG8_SCHED; PG8_MMA0(0, 0, At, B0); PG8_MMA0(0, 1, At, B1); PG8_SCHED; PG8_BAR; PG8_PRIO0; PG8_SCHED;
            if constexpr (MODE == 0) PG8_LDA(At, 1, 1); if constexpr (MODE == 2) PG8_LDB2(B0, 1); PG8_STAGE(PG8_SB(1, 0), b3, voffB); PG8_STAGE(PG8_SB(1, 1), b3 + hstep, voffB); PG8_STAGE(PG8_SA(1, 0), a3, voffA);
            PG8_WAIT_VL; PG8_PRIO1; PG8_BAR; PG8_SCHED; if constexpr (MODE == 0) { PG8_MMA0(1, 0, At, B0); PG8_MMA0(1, 1, At, B1); } if constexpr (MODE == 2) { PG8_MMA0(1, 0, At, B0); } PG8_SCHED; PG8_BAR; PG8_PRIO0; PG8_SCHED;
            } else {
            PG8_LDB(B0, 0, 0); PG8_SCHED; PG8_LDA(At, 0, 0); PG8_STAGE(PG8_SA(1, 1), a1 + hstep, voffA);
            PG8_WAIT_L(8); PG8_BAR; PG8_WAIT_L(0); PG8_MMA(0, 0, At, B0); PG8_BAR; PG8_SCHED;
            PG8_LDB(B1, 0, 1); PG8_STAGE(PG8_SB(0, 0), b2, voffB);
            PG8_BAR; PG8_WAIT_L(0); PG8_MMA(0, 1, At, B1); PG8_BAR;
            PG8_LDA(At, 0, 1); PG8_STAGE(PG8_SA(0, 0), a2, voffA);
            PG8_BAR; PG8_WAIT_L(0); PG8_MMA(1, 0, At, B0); PG8_BAR; PG8_SCHED;
            PG8_STAGE(PG8_SB(0, 1), b2 + hstep, voffB);
            PG8_WAIT_V(6); PG8_BAR; PG8_MMA(1, 1, At, B1); PG8_BAR;
            PG8_LDB(B0, 1, 0); PG8_SCHED; PG8_LDA(At, 1, 0); PG8_STAGE(PG8_SA(0, 1), a2 + hstep, voffA);
            PG8_WAIT_L(8); PG8_BAR; PG8_WAIT_L(0); PG8_MMA(0, 0, At, B0); PG8_BAR; PG8_SCHED;
            PG8_LDB(B1, 1, 1); PG8_STAGE(PG8_SB(1, 0), b3, voffB);
            PG8_BAR; PG8_WAIT_L(0); PG8_MMA(0, 1, At, B1); PG8_BAR;
            PG8_LDA(At, 1, 1); PG8_STAGE(PG8_SA(1, 0), a3, voffA);
            PG8_BAR; PG8_WAIT_L(0); PG8_MMA(1, 0, At, B0); PG8_BAR; PG8_SCHED;
            PG8_STAGE(PG8_SB(1, 1), b3 + hstep, voffB);
            PG8_WAIT_V(6); PG8_BAR; PG8_MMA(1, 1, At, B1); PG8_BAR;
            }
        }
        if constexpr (ALIGN_EPI) { if (wr == 0) PG8_BAR; }
        if constexpr (!Epi::AFTER_DRAIN) { if constexpr (Epi::SS_LDS) E.with_lds(acc, cur, wr, wc, fr, fq, (const PG8_LAS float*)(lds + PG8_SS_OFF + sslot * 1024)); else E(acc, cur, wr, wc, fr, fq); S.done(cur); }
        if (!has_next) break;
#pragma unroll
        for (int a = 0; a < 2; ++a)
#pragma unroll
            for (int b = 0; b < 2; ++b)
#pragma unroll
                for (int m = 0; m < 4; ++m)
#pragma unroll
                    for (int n = 0; n < 2; ++n) acc[a][b][m][n] = (f32x4){0.f, 0.f, 0.f, 0.f};
        cur = nxt; cA = nA; cB = nB; ++ui; sslot = sslot == 2 ? 0 : sslot + 1;
        if constexpr (ALIGN_EPI) { if (wr == 1) PG8_BAR; }
    }
    PG8_WAIT_V(0);
    if constexpr (!ALIGN_EPI) { if (wr == 0) PG8_BAR; }
    PG8_BAR;
    if constexpr (Epi::AFTER_DRAIN) { E.fused(acc, cur, wr, wc, fr, fq, lds, wid, lane); S.done(cur); }
#undef PG8_SA
#undef PG8_SB
#undef PG8_STAGE
#undef PG8_LDA
#undef PG8_LDB
#undef PG8_MMA
#undef PG8_MMA0
#undef PG8_PRIO1
#undef PG8_PRIO0
#undef PG8_WAIT_L0B
#undef PG8_WAIT_VL
#undef PG8_STAGE_A1
#undef PG8_LDB2
#undef PG8_WAIT_V
#undef PG8_WAIT_L
#undef PG8_BAR
#undef PG8_SCHED
}
}

constexpr int D = 4096, NB = 4, TT = 2048, DEPTH = 2, SB = 8, STT = 16;
constexpr int MP = NB * TT;
constexpr int MS = SB * STT;
constexpr int MV = MP + MS;
constexpr int MPAD = 8448;
constexpr int INC = 9744, INP = 9984, DFF = 11008;
constexpr int A_Q = 0, A_F = 1024, A_I = 2048, A_G = 3072, B_Q = 4096, B_K = 6144, B_V = 6400, C_Q = 6656, C_K = 7168, C_V = 7680, C_R = 8704, C_A = 9728;
constexpr int MIX_A = 0, MIX_B = 1024, MIX_C = 3072;
constexpr float EPS = 1e-6f;
constexpr int NSLOT = 1088;
constexpr int ROPE_N = 2064;
constexpr size_t O_YP = 0, O_YS = O_YP + (size_t)MP * D, O_KP = O_YS + (size_t)MS * D, O_VP = O_KP + (size_t)DEPTH * NB * 128 * 256, O_SAP = O_VP + (size_t)DEPTH * NB * 128 * 256,
                 O_SCP = O_SAP + (size_t)DEPTH * NB * 8 * 128 * 128, O_KS = O_SCP + (size_t)DEPTH * NB * 8 * 64 * 128, O_VS = O_KS + (size_t)DEPTH * SB * 16 * 256,
                 O_SAS = O_VS + (size_t)DEPTH * SB * 16 * 256, O_SCS = O_SAS + (size_t)DEPTH * SB * 8 * 128 * 128, O_END = O_SCS + (size_t)DEPTH * SB * 8 * 64 * 128;
constexpr size_t al256(size_t x) { return (x + 255) & ~(size_t)255; }
constexpr size_t WS_CTL = 0, CTL_BYTES = 1u << 20;
constexpr size_t WS_ROPE = WS_CTL + CTL_BYTES;
constexpr size_t WS_LB = WS_ROPE + al256((size_t)ROPE_N * 32 * 2 * 4);
constexpr size_t WS_X = WS_LB + al256(3 * 2 * 1024 * 4);
constexpr size_t WS_XN = WS_X + (size_t)MPAD * D * 4;
constexpr size_t WS_PROJ = WS_XN + (size_t)MPAD * D * 2;
constexpr size_t WS_MIX = WS_PROJ + (size_t)MPAD * INP * 2;
constexpr size_t WS_ACT = WS_MIX + (size_t)MPAD * D * 2;
constexpr size_t WS_W1 = WS_ACT + (size_t)MPAD * DFF * 2;
constexpr size_t WS_W2 = WS_W1 + 2 * (size_t)INP * D * 2;
constexpr size_t WS_W3 = WS_W2 + 2 * (size_t)D * D * 2;
constexpr size_t WS_W4 = WS_W3 + 2 * (size_t)2 * DFF * D * 2;
constexpr size_t WS_UA = WS_W4 + 2 * (size_t)D * DFF * 2;
constexpr size_t WS_UC = WS_UA + (size_t)NSLOT * 128 * 128 * 4;
constexpr size_t WS_DA = WS_UC + (size_t)NSLOT * 128 * 64 * 4;
constexpr size_t WS_DC = WS_DA + (size_t)NSLOT * 128 * 4;
constexpr size_t WS_SSP = WS_DC + (size_t)NSLOT * 64 * 4;
constexpr size_t WS_SSA = WS_SSP + (size_t)MPAD * 64 * 4;
constexpr size_t WS_SSB = WS_SSA + (size_t)MPAD * 4;
constexpr size_t WS_PART = WS_SSB + (size_t)MPAD * 4;
constexpr size_t WS_STA = WS_PART + (size_t)16 * MS * D * 4;
constexpr size_t WS_STC = WS_STA + (size_t)NSLOT * 128 * 128 * 2;
constexpr size_t WS_CAB = WS_STC + (size_t)NSLOT * 128 * 64 * 2;
constexpr size_t WS_GU = WS_CAB + (size_t)MPAD * 16 * 2;
constexpr size_t WS_END = WS_GU + (size_t)MS * 2 * DFF * 4;
constexpr int CW_BAR = 4096, CW_RANK = 8192, CW_FALL = 8192 + 64 * 8;
constexpr int RING_BYTES = 131072;
constexpr int MISC_OFF = RING_BYTES + 320;
constexpr int LDS_BYTES = 147456;
constexpr int NWAVES = 8;

#define GAS __attribute__((address_space(1)))
#define LAS __attribute__((address_space(3)))
typedef unsigned short bf16;
typedef unsigned v4u __attribute__((ext_vector_type(4)));
typedef unsigned v2u __attribute__((ext_vector_type(2)));
typedef float f32x4 __attribute__((ext_vector_type(4)));
typedef short bf16x8 __attribute__((ext_vector_type(8)));
typedef short bf16x4 __attribute__((ext_vector_type(4)));
#define LDS_WAIT() asm volatile("s_waitcnt lgkmcnt(0)" ::: "memory")
#define VM_WAIT() asm volatile("s_waitcnt vmcnt(0)" ::: "memory")
typedef float f32x2_t __attribute__((ext_vector_type(2))); typedef __bf16 bf16x2_t __attribute__((ext_vector_type(2)));
__device__ __forceinline__ unsigned pk2(float lo, float hi) { const f32x2_t v = {lo, hi}; const bf16x2_t b = __builtin_convertvector(v, bf16x2_t); return __builtin_bit_cast(unsigned, b); }
__device__ __forceinline__ unsigned f2bf(float f) { return pk2(f, f) & 0xffffu; }
__device__ __forceinline__ float bf2f(unsigned short b) { return __builtin_bit_cast(float, (unsigned)b << 16); }
__device__ __forceinline__ float bflo(unsigned w) { return __builtin_bit_cast(float, w << 16); }
__device__ __forceinline__ float bfhi(unsigned w) { return __builtin_bit_cast(float, w & 0xffff0000u); }

#define XB_TMO      128
#define XB_XCNT(j)  (256  + 64 * (j))
#define XB_XSUB(j)  (1280 + 64 * (j))
#define XB_XGEN(j)  (2304 + 64 * (j))
#define XB_TOP      3328
#define XB_TOPGEN   3392
#define XCD_BAR_WORDS 3456
#define XB_SPIN_CAP (1u << 18)

__device__ __forceinline__ unsigned xb_ld(unsigned* p)              { return __hip_atomic_load(p, __ATOMIC_RELAXED, __HIP_MEMORY_SCOPE_AGENT); }
__device__ __forceinline__ unsigned xb_add(unsigned* p, unsigned v) { return __hip_atomic_fetch_add(p, v, __ATOMIC_RELAXED, __HIP_MEMORY_SCOPE_AGENT); }
__device__ __forceinline__ unsigned xb_xcc_id() { return (unsigned)__builtin_amdgcn_s_getreg((3 << 11) | 20) & 0xFu; }
#define XB_SPIN(cond, bar) do { unsigned _sp = 0; while (cond) { __builtin_amdgcn_s_sleep(1); \
    if ((++_sp & 255u) == 0u) { if (xb_ld(&(bar)[XB_TMO])) break; if (_sp > XB_SPIN_CAP) { atomicAdd(&(bar)[XB_TMO], 1u); break; } } } } while (0)

struct XcdBarrier {
    unsigned* bar; unsigned x;
    volatile LAS unsigned* st;
};

__device__ __forceinline__ XcdBarrier xcd_barrier_post(unsigned* bar, volatile LAS unsigned* st) {
    XcdBarrier b; b.bar = bar; b.x = xb_xcc_id(); b.st = st;
    if (threadIdx.x == 0) (void)xb_add(&bar[XB_XCNT(b.x)], 1u);
    return b;
}
__device__ __forceinline__ void xcd_barrier_complete(unsigned* bar, unsigned x, unsigned& nloc, unsigned& nx) {
    const unsigned G = gridDim.x * gridDim.y * gridDim.z;
    unsigned sum, cnt, mine, sp = 0u;
    for (;;) {
        sum = 0u; cnt = 0u; mine = 0u;
#pragma unroll
        for (unsigned j = 0; j < 16; ++j) { const unsigned c = xb_ld(&bar[XB_XCNT(j)]); sum += c; cnt += (c > 0u) ? 1u : 0u; mine = (j == x) ? c : mine; }
        if (sum == G) break;
        __builtin_amdgcn_s_sleep(1);
        if ((++sp & 255u) == 0u) { if (xb_ld(&bar[XB_TMO])) break; if (sp > XB_SPIN_CAP) { atomicAdd(&bar[XB_TMO], 1u); break; } }
    }
    nloc = mine > 0u ? mine : 1u; nx = cnt > 0u ? cnt : 1u;
}

__device__ __forceinline__ void xcd_barrier(const XcdBarrier& b) {
    asm volatile("s_waitcnt vmcnt(0)" ::: "memory");
    __syncthreads();
    if (threadIdx.x == 0) {
        unsigned* bar = b.bar;
        __builtin_amdgcn_s_waitcnt(0);
        unsigned nloc = b.st[0], nx = b.st[1];
        if (nloc == 0u) { xcd_barrier_complete(bar, b.x, nloc, nx); b.st[0] = nloc; b.st[1] = nx; }
        const unsigned old = xb_add(&bar[XB_XSUB(b.x)], 1u);
        const unsigned gen = old / nloc;
        if (old + 1u == (gen + 1u) * nloc) {
            __builtin_amdgcn_fence(__ATOMIC_RELEASE, "agent");
            asm volatile("s_waitcnt vmcnt(0)" ::: "memory");
            const unsigned og = xb_add(&bar[XB_TOP], 1u);
            const unsigned tg = og / nx;
            if (og + 1u == (tg + 1u) * nx) xb_add(&bar[XB_TOPGEN], 1u);
            else XB_SPIN(xb_ld(&bar[XB_TOPGEN]) == tg, bar);
            __builtin_amdgcn_fence(__ATOMIC_ACQUIRE, "agent");
            xb_add(&bar[XB_XGEN(b.x)], 1u);
            asm volatile("s_waitcnt vmcnt(0)" ::: "memory");
        } else {
            XB_SPIN(xb_ld(&bar[XB_XGEN(b.x)]) == gen, bar);
            __builtin_amdgcn_fence(__ATOMIC_ACQUIRE, "agent");
            asm volatile("s_waitcnt vmcnt(0)" ::: "memory");
        }
    }
    __syncthreads();
}


struct Args { const float* in[19]; float* out; unsigned char* ws; int ph_lo, ph_hi; };

__device__ __forceinline__ float wave_sum(float v) {
#pragma unroll
    for (int o = 1; o < 64; o <<= 1) v += __shfl_xor(v, o);
    return v;
}

template <int MODE>
__device__ __forceinline__ void transpose_item(const float* W, int K, int N, bf16* WT, const float* gain, int item, int lane) {
    const int nblk = (N + 63) / 64, kb = item / nblk, nb = item - kb * nblk, k0 = 64 * kb, n0 = 64 * nb;
    const int q = lane >> 4, p = lane & 15, n = n0 + 4 * p;
    if (n >= N) return;
    const float* src = W + (size_t)(k0 + 16 * q) * N + n;
    f32x4 v[16];
#pragma unroll
    for (int i = 0; i < 16; ++i) v[i] = *(const f32x4*)(src + (size_t)i * N);
    if (gain) {
#pragma unroll
        for (int i = 0; i < 4; ++i) { const f32x4 g4 = *(const f32x4*)(gain + k0 + 16 * q + 4 * i); v[4 * i] = v[4 * i] * g4.x; v[4 * i + 1] = v[4 * i + 1] * g4.y; v[4 * i + 2] = v[4 * i + 2] * g4.z; v[4 * i + 3] = v[4 * i + 3] * g4.w; } }
#pragma unroll
    for (int cc = 0; cc < 4; ++cc) { const int nn = n + cc; int orow = nn;
        if (MODE == 1) { const int half = nn >= DFF ? 1 : 0, nn2 = nn - half * DFF; orow = 256 * (nn2 >> 7) + 128 * half + (nn2 & 127); }
        unsigned w[8];
#pragma unroll
        for (int i = 0; i < 8; ++i) w[i] = pk2(v[2 * i][cc], v[2 * i + 1][cc]);
        v4u* dst = (v4u*)(WT + (((size_t)(orow >> 7) * (K / 64) + kb) * 128 + (orow & 127)) * 64 + 16 * q); dst[0] = (v4u){w[0], w[1], w[2], w[3]}; dst[1] = (v4u){w[4], w[5], w[6], w[7]}; }
}
template <int MODE>
__device__ __forceinline__ void norm_row(const float* src, const bf16* xsrc, const float* g, bf16* xb, float* ssout, float* fout, int lane) {
    if (MODE == 0) {
        const f32x4* s4 = (const f32x4*)src + lane; f32x4 v[16]; float ss = 0.f;
#pragma unroll
        for (int j = 0; j < 16; ++j) { v[j] = s4[64 * j]; ss += (v[j].x * v[j].x + v[j].y * v[j].y) + (v[j].z * v[j].z + v[j].w * v[j].w); }
        ss = wave_sum(ss);
#pragma unroll
        for (int j = 0; j < 16; ++j) { v2u w; w.x = pk2(v[j].x, v[j].y); w.y = pk2(v[j].z, v[j].w); ((v2u*)xb + lane)[64 * j] = w; }
        if (lane == 0) *ssout = ss;
    } else {
        const v4u* s8 = (const v4u*)xsrc + lane; v4u r[8]; float ss = 0.f;
#pragma unroll
        for (int j = 0; j < 8; ++j) { r[j] = s8[64 * j]; const unsigned rw[4] = {r[j].x, r[j].y, r[j].z, r[j].w};
#pragma unroll
            for (int i = 0; i < 4; ++i) { const float a0 = bflo(rw[i]), a1 = bfhi(rw[i]); ss += a0 * a0 + a1 * a1; } }
        ss = wave_sum(ss);
        const float rstd = 1.0f / sqrtf(ss * (1.0f / D) + EPS);
#pragma unroll
        for (int j = 0; j < 8; ++j) { const unsigned rw[4] = {r[j].x, r[j].y, r[j].z, r[j].w}; const f32x4 g0 = *(const f32x4*)(g + 512 * j + 8 * lane), g1 = *(const f32x4*)(g + 512 * j + 8 * lane + 4);
            *(f32x4*)(fout + 512 * j + 8 * lane) = (f32x4){bflo(rw[0]) * rstd * g0.x, bfhi(rw[0]) * rstd * g0.y, bflo(rw[1]) * rstd * g0.z, bfhi(rw[1]) * rstd * g0.w};
            *(f32x4*)(fout + 512 * j + 8 * lane + 4) = (f32x4){bflo(rw[2]) * rstd * g1.x, bfhi(rw[2]) * rstd * g1.y, bflo(rw[3]) * rstd * g1.z, bfhi(rw[3]) * rstd * g1.w}; }
    }
}
__device__ __forceinline__ void final_rows2(const bf16* XBp, const float* g, float* fout, int m0, int m1, int lane) {
    v4u r[2][8]; float ss[2] = {0.f, 0.f};
#pragma unroll
    for (int k = 0; k < 2; ++k) { const v4u* s8 = (const v4u*)(XBp + (size_t)(k ? m1 : m0) * D) + lane;
#pragma unroll
        for (int j = 0; j < 8; ++j) r[k][j] = s8[64 * j]; }
#pragma unroll
    for (int k = 0; k < 2; ++k)
#pragma unroll
        for (int j = 0; j < 8; ++j) { const unsigned rw[4] = {r[k][j].x, r[k][j].y, r[k][j].z, r[k][j].w};
#pragma unroll
            for (int i = 0; i < 4; ++i) { const float a0 = bflo(rw[i]), a1 = bfhi(rw[i]); ss[k] += a0 * a0 + a1 * a1; } }
    ss[0] = wave_sum(ss[0]); ss[1] = wave_sum(ss[1]);
#pragma unroll
    for (int k = 0; k < 2; ++k) { if (k == 1 && m1 == m0) break; const float rstd = 1.0f / sqrtf(ss[k] * (1.0f / D) + EPS); float* fo = fout + (size_t)(k ? m1 : m0) * D;
#pragma unroll
        for (int j = 0; j < 8; ++j) { const unsigned rw[4] = {r[k][j].x, r[k][j].y, r[k][j].z, r[k][j].w}; const f32x4 g0 = *(const f32x4*)(g + 512 * j + 8 * lane), g1 = *(const f32x4*)(g + 512 * j + 8 * lane + 4);
            __builtin_nontemporal_store((f32x4){bflo(rw[0]) * rstd * g0.x, bfhi(rw[0]) * rstd * g0.y, bflo(rw[1]) * rstd * g0.z, bfhi(rw[1]) * rstd * g0.w}, (f32x4*)(fo + 512 * j + 8 * lane));
            __builtin_nontemporal_store((f32x4){bflo(rw[2]) * rstd * g1.x, bfhi(rw[2]) * rstd * g1.y, bflo(rw[3]) * rstd * g1.z, bfhi(rw[3]) * rstd * g1.w}, (f32x4*)(fo + 512 * j + 8 * lane + 4)); } }
}
__device__ __forceinline__ void prologue(const Args& a, LAS unsigned char* lds, int tid, int lane, int wave, int bid, int G) {
    unsigned char* ws = a.ws;
    const int gw = bid * NWAVES + wave, NGW = G * NWAVES;
    constexpr int I1 = 64 * 153, I2 = 64 * 64, I3 = 64 * 344, I4 = 172 * 64, IL = I1 + I2 + I3 + I4;
    for (int it = gw; it < 2 * IL; it += NGW) {
        const int l = it >= IL ? 1 : 0; int r = it - l * IL;
        if (r < I1) { transpose_item<0>(a.in[7] + (size_t)l * D * INC, D, INC, (bf16*)(ws + WS_W1) + (size_t)l * INP * D, a.in[6] + (size_t)l * D, r, lane); continue; } r -= I1;
        if (r < I2) { transpose_item<0>(a.in[14] + (size_t)l * D * D, D, D, (bf16*)(ws + WS_W2) + (size_t)l * D * D, nullptr, r, lane); continue; } r -= I2;
        if (r < I3) { transpose_item<1>(a.in[16] + (size_t)l * D * 2 * DFF, D, 2 * DFF, (bf16*)(ws + WS_W3) + (size_t)l * 2 * DFF * D, a.in[15] + (size_t)l * D, r, lane); continue; } r -= I3;
        transpose_item<0>(a.in[17] + (size_t)l * DFF * D, DFF, D, (bf16*)(ws + WS_W4) + (size_t)l * D * DFF, nullptr, r, lane);
    }
    const int gt = bid * 512 + tid, NT = G * 512; const v4u z4 = {0u, 0u, 0u, 0u};
    {
      constexpr int NX = (MPAD - MV) * D * 4 / 16, NH = NX / 2;
      for (int i = gt; i < NH; i += NT) { ((v4u*)(ws + WS_XN + (size_t)MV * D * 2))[i] = z4; ((v4u*)(ws + WS_MIX + (size_t)MV * D * 2))[i] = z4; } }
    for (int m = gw; m < MV; m += 2 * NGW) { const int m1 = m + NGW < MV ? m + NGW : m;
        const float* s0 = m < MP ? a.in[0] + (size_t)m * D : a.in[1] + (size_t)(m - MP) * D; const float* s1 = m1 < MP ? a.in[0] + (size_t)m1 * D : a.in[1] + (size_t)(m1 - MP) * D;
        f32x4 v[2][16]; float ss[2] = {0.f, 0.f};
#pragma unroll
        for (int j = 0; j < 16; ++j) { v[0][j] = ((const f32x4*)s0 + lane)[64 * j]; v[1][j] = ((const f32x4*)s1 + lane)[64 * j]; }
#pragma unroll
        for (int k = 0; k < 2; ++k)
#pragma unroll
            for (int j = 0; j < 16; ++j) ss[k] += (v[k][j].x * v[k][j].x + v[k][j].y * v[k][j].y) + (v[k][j].z * v[k][j].z + v[k][j].w * v[k][j].w);
        ss[0] = wave_sum(ss[0]); ss[1] = wave_sum(ss[1]);
#pragma unroll
        for (int k = 0; k < 2; ++k) { if (k == 1 && m1 == m) break; const int mm = k ? m1 : m; bf16* xb = (bf16*)(ws + WS_XN) + (size_t)mm * D;
#pragma unroll
            for (int j = 0; j < 16; ++j) { v2u w; w.x = pk2(v[k][j].x, v[k][j].y); w.y = pk2(v[k][j].z, v[k][j].w); ((v2u*)xb + lane)[64 * j] = w; }
            if (lane == 0) ((float*)(ws + WS_SSA))[mm] = ss[k]; } }
    for (int i = gt; i < MPAD - MV; i += NT) { ((float*)(ws + WS_SSA))[MV + i] = 0.f; ((float*)(ws + WS_SSB))[MV + i] = 0.f; }
    { float* rc = (float*)(ws + WS_ROPE); float* rs = rc + ROPE_N * 32;
      for (int i = gt; i < ROPE_N * 32; i += NT) { const int p = i >> 5, k = i & 31; const float pos = (float)(p < 2048 ? p : 4096 + (p - 2048));
          const float inv = powf(10000.0f, -(float)k / 32.0f); const float ang = pos * inv; float sn, cs; sincosf(ang, &sn, &cs); rc[i] = cs; rs[i] = sn; }
      float* lba = (float*)(ws + WS_LB); float* lbc = lba + 2048; float* lbm = lbc + 2048;
      for (int i = gt; i < 1024; i += NT) { const float z0 = a.in[8][i], z1 = a.in[8][1024 + i], mx = fmaxf(z0, z1), e0 = expf(z0 - mx), e1 = expf(z1 - mx), p0 = e0 / (e0 + e1), p1 = e1 / (e0 + e1);
          const float lb0 = p0 - p0, lb1 = (p0 + p1) - p0;
          lba[i] = logf(fmaxf(lb0, 1e-30f)); lbc[i] = log1pf(-lb0); lbm[i] = 1.0f - lb0;
          lba[1024 + i] = logf(fmaxf(lb1, 1e-30f)); lbc[1024 + i] = log1pf(-lb1); lbm[1024 + i] = 1.0f - lb1; } }
}

template <int KSTEPS>
__device__ __forceinline__ f32x4 tile_mma(f32x4 acc, const LAS bf16* Xrow, const LAS bf16* Yrow) {
#pragma unroll
    for (int ks = 0; ks < KSTEPS; ++ks) { const bf16x8 x = *(const LAS bf16x8*)(Xrow + 32 * ks), y = *(const LAS bf16x8*)(Yrow + 32 * ks);
        acc = __builtin_amdgcn_mfma_f32_16x16x32_bf16(x, y, acc, 0, 0, 0); }
    return acc;
}

#define LBAR() do { asm volatile("s_waitcnt lgkmcnt(0)" ::: "memory"); __builtin_amdgcn_s_barrier(); asm volatile("" ::: "memory"); } while (0)
__device__ __forceinline__ void swa_item(const Args& a, LAS unsigned char* lds, int l, int item, int tid, int lane, int wave) {
    unsigned char* ws = a.ws;
    const bf16* PROJ = (const bf16*)(ws + WS_PROJ); bf16* MIX = (bf16*)(ws + WS_MIX);
    const float* rc = (const float*)(ws + WS_ROPE); const float* rs = rc + ROPE_N * 32;
    LAS bf16* Ks = (LAS bf16*)lds;
    LAS bf16* Vt = (LAS bf16*)(lds + 27648);
    const bool samp = item >= 512;
    int b, kvh, c;
    if (!samp) { kvh = item & 3; c = (item >> 2) & 31; b = item >> 7; } else { const int j = item - 512; kvh = j & 3; b = j >> 2; c = 0; }
#pragma unroll 4
    for (int i = 0; i < 12; ++i) { const int p = tid + 512 * i, key = p >> 5, pi = p & 31, blk = key >> 6, kr = key & 63; float r1 = 0.f, r2 = 0.f;
        if (!samp) { const int cj = c - 2 + blk;
            if (cj >= 0) { const size_t row = (size_t)b * TT + cj * 64 + kr; const bf16* kp = PROJ + row * INP + B_K + kvh * 64 + pi; const float k1 = bf2f(kp[0]), k2 = bf2f(kp[32]);
                const int pidx = (cj * 64 + kr) * 32 + pi; const float cs = rc[pidx], sn = rs[pidx]; r1 = k1 * cs - k2 * sn; r2 = k2 * cs + k1 * sn;
                if (blk == 2 && c >= 30) { float* ko = a.out + O_KP + ((((size_t)l * NB + b) * 128 + (c - 30) * 64 + kr) * 4 + kvh) * 64 + pi; ko[0] = r1; ko[32] = r2; } }
        } else {
            if (blk < 2) { const float* kp = a.in[2] + ((((size_t)l * SB + b) * 128 + blk * 64 + kr) * 4 + kvh) * 64 + pi; r1 = kp[0]; r2 = kp[32]; }
            else if (kr < 16) { const size_t row = (size_t)MP + b * 16 + kr; const bf16* kp = PROJ + row * INP + B_K + kvh * 64 + pi; const float k1 = bf2f(kp[0]), k2 = bf2f(kp[32]);
                const int pidx = (2048 + kr) * 32 + pi; const float cs = rc[pidx], sn = rs[pidx]; r1 = k1 * cs - k2 * sn; r2 = k2 * cs + k1 * sn;
                float* ko = a.out + O_KS + ((((size_t)l * SB + b) * 16 + kr) * 4 + kvh) * 64 + pi; ko[0] = r1; ko[32] = r2; }
        }
        Ks[key * 72 + pi] = (bf16)f2bf(r1); Ks[key * 72 + pi + 32] = (bf16)f2bf(r2); }
#pragma unroll 4
    for (int i = 0; i < 24; ++i) { const int e = tid + 512 * i, key = e >> 6, d = e & 63, blk = key >> 6, kr = key & 63; float v = 0.f;
        if (!samp) { const int cj = c - 2 + blk;
            if (cj >= 0) { const size_t row = (size_t)b * TT + cj * 64 + kr; v = bf2f(PROJ[row * INP + B_V + kvh * 64 + d]);
                if (blk == 2 && c >= 30) a.out[O_VP + ((((size_t)l * NB + b) * 128 + (c - 30) * 64 + kr) * 4 + kvh) * 64 + d] = v; }
        } else {
            if (blk < 2) v = a.in[3][((((size_t)l * SB + b) * 128 + blk * 64 + kr) * 4 + kvh) * 64 + d];
            else if (kr < 16) { const size_t row = (size_t)MP + b * 16 + kr; v = bf2f(PROJ[row * INP + B_V + kvh * 64 + d]);
                a.out[O_VS + ((((size_t)l * SB + b) * 16 + kr) * 4 + kvh) * 64 + d] = v; }
        }
        Vt[d * 200 + key] = (bf16)f2bf(v); }
    __syncthreads();
    const int fr = lane & 15, fq = lane >> 4, hq = kvh * 8 + wave;
    const float sink = a.in[10][l * 32 + hq];
    unsigned tvm;
    if (!samp) tvm = c >= 2 ? 0xfffu : (c == 1 ? 0xff0u : 0xf00u); else tvm = 0x1ffu;
    const int nmb = samp ? 1 : 4;
    for (int mb = 0; mb < nmb; ++mb) {
        const size_t qrow = samp ? (size_t)MP + b * 16 + fr : (size_t)b * TT + c * 64 + 16 * mb + fr;
        const int pidx = (samp ? 2048 + fr : c * 64 + 16 * mb + fr) * 32 + 8 * fq;
        const v4u x1 = *(const v4u*)(PROJ + qrow * INP + B_Q + hq * 64 + 8 * fq), x2 = *(const v4u*)(PROJ + qrow * INP + B_Q + hq * 64 + 32 + 8 * fq);
        const f32x4 c0 = *(const f32x4*)(rc + pidx), c1 = *(const f32x4*)(rc + pidx + 4), s0 = *(const f32x4*)(rs + pidx), s1 = *(const f32x4*)(rs + pidx + 4);
        const float cs[8] = {c0.x, c0.y, c0.z, c0.w, c1.x, c1.y, c1.z, c1.w}, sn[8] = {s0.x, s0.y, s0.z, s0.w, s1.x, s1.y, s1.z, s1.w};
        const unsigned xa[4] = {x1.x, x1.y, x1.z, x1.w}, xb[4] = {x2.x, x2.y, x2.z, x2.w};
        unsigned qa[4], qb[4];
#pragma unroll
        for (int j = 0; j < 4; ++j) { const float a0 = bflo(xa[j]), a1 = bfhi(xa[j]), b0 = bflo(xb[j]), b1 = bfhi(xb[j]);
            qa[j] = pk2(a0 * cs[2 * j] - b0 * sn[2 * j], a1 * cs[2 * j + 1] - b1 * sn[2 * j + 1]);
            qb[j] = pk2(b0 * cs[2 * j] + a0 * sn[2 * j], b1 * cs[2 * j + 1] + a1 * sn[2 * j + 1]); }
        const bf16x8 bq0 = __builtin_bit_cast(bf16x8, (v4u){qa[0], qa[1], qa[2], qa[3]}), bq1 = __builtin_bit_cast(bf16x8, (v4u){qb[0], qb[1], qb[2], qb[3]});
        f32x4 s[12]; float mx = sink;
#pragma unroll
        for (int kt = 0; kt < 12; ++kt) { s[kt] = (f32x4){0.f, 0.f, 0.f, 0.f};
            if ((tvm >> kt) & 1u) { const LAS bf16* kp = Ks + (16 * kt + fr) * 72 + 8 * fq;
                f32x4 acc = __builtin_amdgcn_mfma_f32_16x16x32_bf16(*(const LAS bf16x8*)kp, bq0, (f32x4){0.f, 0.f, 0.f, 0.f}, 0, 0, 0);
                acc = __builtin_amdgcn_mfma_f32_16x16x32_bf16(*(const LAS bf16x8*)(kp + 32), bq1, acc, 0, 0, 0);
                s[kt] = acc * 0.125f; mx = fmaxf(mx, fmaxf(fmaxf(s[kt].x, s[kt].y), fmaxf(s[kt].z, s[kt].w))); } }
        mx = fmaxf(mx, __shfl_xor(mx, 16)); mx = fmaxf(mx, __shfl_xor(mx, 32));
        float sum = 0.f;
#pragma unroll
        for (int kt = 0; kt < 12; ++kt) { if ((tvm >> kt) & 1u) { s[kt].x = __expf(s[kt].x - mx); s[kt].y = __expf(s[kt].y - mx); s[kt].z = __expf(s[kt].z - mx); s[kt].w = __expf(s[kt].w - mx);
                sum += (s[kt].x + s[kt].y) + (s[kt].z + s[kt].w); } }
        sum += __shfl_xor(sum, 16); sum += __shfl_xor(sum, 32); sum += __expf(sink - mx);
        const float inv = 1.0f / sum;
        f32x4 o[4];
#pragma unroll
        for (int dt = 0; dt < 4; ++dt) o[dt] = (f32x4){0.f, 0.f, 0.f, 0.f};
#pragma unroll
        for (int u = 0; u < 6; ++u) { if ((tvm >> (2 * u)) & 3u) {
                const bf16x8 bp = __builtin_bit_cast(bf16x8, (v4u){pk2(s[2 * u].x, s[2 * u].y), pk2(s[2 * u].z, s[2 * u].w), pk2(s[2 * u + 1].x, s[2 * u + 1].y), pk2(s[2 * u + 1].z, s[2 * u + 1].w)});
#pragma unroll
                for (int dt = 0; dt < 4; ++dt) { const LAS bf16* vp = Vt + (16 * dt + fr) * 200 + 32 * u + 4 * fq;
                    const v2u lo = *(const LAS v2u*)vp, hi = *(const LAS v2u*)(vp + 16);
                    o[dt] = __builtin_amdgcn_mfma_f32_16x16x32_bf16(__builtin_bit_cast(bf16x8, (v4u){lo.x, lo.y, hi.x, hi.y}), bp, o[dt], 0, 0, 0); } } }
        bf16* op = MIX + qrow * D + MIX_B + hq * 64 + 4 * fq;
#pragma unroll
        for (int dt = 0; dt < 4; ++dt) { v2u w; w.x = pk2(o[dt].x * inv, o[dt].y * inv); w.y = pk2(o[dt].z * inv, o[dt].w * inv); *(v2u*)(op + 16 * dt) = w; }
    }
    __syncthreads();
}

__device__ __forceinline__ void swa_prompt_item(const Args& a, LAS unsigned char* lds, int l, int item, int tid, int lane, int wave) {
    unsigned char* ws = a.ws;
    const bf16* PROJ = (const bf16*)(ws + WS_PROJ); bf16* MIX = (bf16*)(ws + WS_MIX);
    const float* rc = (const float*)(ws + WS_ROPE); const float* rs = rc + ROPE_N * 32;
    LAS bf16* Ks = (LAS bf16*)lds;
    LAS bf16* Vr = (LAS bf16*)(lds + 27648);
    LAS bf16* Vt = (LAS bf16*)(lds + 55296);
    LAS float* Cc = (LAS float*)(lds + 80896);
    LAS float* Cs = Cc + 64 * 32;
    const int kvh = item & 3, c = (item >> 2) & 31, b = item >> 7;
    const int fr = lane & 15, fq = lane >> 4, hq = kvh * 8 + wave;
    const v4u z4 = {0u, 0u, 0u, 0u}; const f32x4 zf = {0.f, 0.f, 0.f, 0.f};
    v4u kreg[3], vreg[3]; f32x4 creg[3], sreg[3], xq[4][2];
#pragma unroll
    for (int j = 0; j < 3; ++j) { const int ci = tid + 512 * j, key = ci >> 3, c8 = ci & 7, cj = c - 2 + (key >> 6); kreg[j] = z4; vreg[j] = z4; creg[j] = zf; sreg[j] = zf;
        if (cj >= 0) { const bf16* p = PROJ + ((size_t)b * TT + cj * 64 + (key & 63)) * INP + kvh * 64 + 8 * c8; kreg[j] = *(const v4u*)(p + B_K); vreg[j] = *(const v4u*)(p + B_V);
            const int pidx = (cj * 64 + (key & 63)) * 32 + 4 * c8; creg[j] = *(const f32x4*)(rc + pidx); sreg[j] = *(const f32x4*)(rs + pidx); } }
#pragma unroll
    for (int mb = 0; mb < 4; ++mb) { const bf16* p = PROJ + ((size_t)b * TT + c * 64 + 16 * mb + fr) * INP + B_Q + hq * 64 + 8 * fq; xq[mb][0] = __builtin_bit_cast(f32x4, *(const v4u*)p); xq[mb][1] = __builtin_bit_cast(f32x4, *(const v4u*)(p + 32)); }
    const float sink = a.in[10][l * 32 + hq];
#pragma unroll
    for (int j = 0; j < 3; ++j) { const int ci = tid + 512 * j, key = ci >> 3, c8 = ci & 7; *(LAS v4u*)(Ks + key * 72 + 8 * c8) = kreg[j]; *(LAS v4u*)(Vr + key * 72 + 8 * c8) = vreg[j];
        if ((key >> 6) == 2 && c >= 30) { float* vo = a.out + O_VP + ((((size_t)l * NB + b) * 128 + (c - 30) * 64 + (key & 63)) * 4 + kvh) * 64 + 8 * c8;
            *(f32x4*)vo = (f32x4){bflo(vreg[j].x), bfhi(vreg[j].x), bflo(vreg[j].y), bfhi(vreg[j].y)}; *(f32x4*)(vo + 4) = (f32x4){bflo(vreg[j].z), bfhi(vreg[j].z), bflo(vreg[j].w), bfhi(vreg[j].w)}; } }
    LBAR();
#pragma unroll
    for (int j = 0; j < 3; ++j) { const int e = tid + 512 * j, key = e >> 3, i4 = (e & 7) * 4;
        const v2u k1 = *(const LAS v2u*)(Ks + key * 72 + i4), k2 = *(const LAS v2u*)(Ks + key * 72 + 32 + i4);
        const float a0 = bflo(k1.x), a1 = bfhi(k1.x), a2 = bflo(k1.y), a3 = bfhi(k1.y), b0 = bflo(k2.x), b1 = bfhi(k2.x), b2 = bflo(k2.y), b3 = bfhi(k2.y);
        const f32x4 cs = creg[j], sn = sreg[j];
        const f32x4 r1 = {a0 * cs.x - b0 * sn.x, a1 * cs.y - b1 * sn.y, a2 * cs.z - b2 * sn.z, a3 * cs.w - b3 * sn.w}, r2 = {b0 * cs.x + a0 * sn.x, b1 * cs.y + a1 * sn.y, b2 * cs.z + a2 * sn.z, b3 * cs.w + a3 * sn.w};
        *(LAS v2u*)(Ks + key * 72 + i4) = (v2u){pk2(r1.x, r1.y), pk2(r1.z, r1.w)}; *(LAS v2u*)(Ks + key * 72 + 32 + i4) = (v2u){pk2(r2.x, r2.y), pk2(r2.z, r2.w)};
        if ((key >> 6) == 2) { *(LAS f32x4*)(Cc + (key & 63) * 32 + i4) = cs; *(LAS f32x4*)(Cs + (key & 63) * 32 + i4) = sn;
            if (c >= 30) { float* ko = a.out + O_KP + ((((size_t)l * NB + b) * 128 + (c - 30) * 64 + (key & 63)) * 4 + kvh) * 64 + i4; *(f32x4*)ko = r1; *(f32x4*)(ko + 32) = r2; } } }
    { const int d = tid & 63, kp = tid >> 6; unsigned w[12];
#pragma unroll
      for (int i = 0; i < 12; ++i) w[i] = (unsigned)Vr[(24 * kp + 2 * i) * 72 + d] | ((unsigned)Vr[(24 * kp + 2 * i + 1) * 72 + d] << 16);
      LAS v4u* dst = (LAS v4u*)(Vt + d * 200 + 24 * kp); dst[0] = (v4u){w[0], w[1], w[2], w[3]}; dst[1] = (v4u){w[4], w[5], w[6], w[7]}; dst[2] = (v4u){w[8], w[9], w[10], w[11]}; }
    LBAR();
    const unsigned tvm = c >= 2 ? 0xfffu : (c == 1 ? 0xff0u : 0xf00u);
#pragma unroll
    for (int mb = 0; mb < 4; ++mb) {
        const size_t qrow = (size_t)b * TT + c * 64 + 16 * mb + fr;
        const LAS float* cp = Cc + (16 * mb + fr) * 32 + 8 * fq; const LAS float* sp = Cs + (16 * mb + fr) * 32 + 8 * fq;
        const f32x4 c0 = *(const LAS f32x4*)cp, c1 = *(const LAS f32x4*)(cp + 4), s0 = *(const LAS f32x4*)sp, s1 = *(const LAS f32x4*)(sp + 4);
        const float cs[8] = {c0.x, c0.y, c0.z, c0.w, c1.x, c1.y, c1.z, c1.w}, sn[8] = {s0.x, s0.y, s0.z, s0.w, s1.x, s1.y, s1.z, s1.w};
        const f32x4 q1 = xq[mb][0], q2 = xq[mb][1];
        const v4u x1 = __builtin_bit_cast(v4u, q1), x2 = __builtin_bit_cast(v4u, q2);
        const unsigned xa[4] = {x1.x, x1.y, x1.z, x1.w}, xb[4] = {x2.x, x2.y, x2.z, x2.w};
        unsigned qa[4], qb[4];
#pragma unroll
        for (int j = 0; j < 4; ++j) { const float a0 = bflo(xa[j]), a1 = bfhi(xa[j]), b0 = bflo(xb[j]), b1 = bfhi(xb[j]);
            qa[j] = pk2(a0 * cs[2 * j] - b0 * sn[2 * j], a1 * cs[2 * j + 1] - b1 * sn[2 * j + 1]);
            qb[j] = pk2(b0 * cs[2 * j] + a0 * sn[2 * j], b1 * cs[2 * j + 1] + a1 * sn[2 * j + 1]); }
        const bf16x8 bq0 = __builtin_bit_cast(bf16x8, (v4u){qa[0], qa[1], qa[2], qa[3]}), bq1 = __builtin_bit_cast(bf16x8, (v4u){qb[0], qb[1], qb[2], qb[3]});
        f32x4 s[12]; float mx = sink;
#pragma unroll
        for (int kt = 0; kt < 12; ++kt) { s[kt] = (f32x4){0.f, 0.f, 0.f, 0.f};
            if ((tvm >> kt) & 1u) { const LAS bf16* kp = Ks + (16 * kt + fr) * 72 + 8 * fq;
                f32x4 acc = __builtin_amdgcn_mfma_f32_16x16x32_bf16(*(const LAS bf16x8*)kp, bq0, (f32x4){0.f, 0.f, 0.f, 0.f}, 0, 0, 0);
                acc = __builtin_amdgcn_mfma_f32_16x16x32_bf16(*(const LAS bf16x8*)(kp + 32), bq1, acc, 0, 0, 0);
                s[kt] = acc * 0.125f; mx = fmaxf(mx, fmaxf(fmaxf(s[kt].x, s[kt].y), fmaxf(s[kt].z, s[kt].w))); } }
        mx = fmaxf(mx, __shfl_xor(mx, 16)); mx = fmaxf(mx, __shfl_xor(mx, 32));
        float sum = 0.f;
#pragma unroll
        for (int kt = 0; kt < 12; ++kt) { if ((tvm >> kt) & 1u) { s[kt].x = __expf(s[kt].x - mx); s[kt].y = __expf(s[kt].y - mx); s[kt].z = __expf(s[kt].z - mx); s[kt].w = __expf(s[kt].w - mx);
                sum += (s[kt].x + s[kt].y) + (s[kt].z + s[kt].w); } }
        sum += __shfl_xor(sum, 16); sum += __shfl_xor(sum, 32); sum += __expf(sink - mx);
        const float inv = 1.0f / sum;
        f32x4 o[4];
#pragma unroll
        for (int dt = 0; dt < 4; ++dt) o[dt] = (f32x4){0.f, 0.f, 0.f, 0.f};
#pragma unroll
        for (int u = 0; u < 6; ++u) { if ((tvm >> (2 * u)) & 3u) {
                const bf16x8 bp = __builtin_bit_cast(bf16x8, (v4u){pk2(s[2 * u].x, s[2 * u].y), pk2(s[2 * u].z, s[2 * u].w), pk2(s[2 * u + 1].x, s[2 * u + 1].y), pk2(s[2 * u + 1].z, s[2 * u + 1].w)});
#pragma unroll
                for (int dt = 0; dt < 4; ++dt) { const LAS bf16* vp = Vt + (16 * dt + fr) * 200 + 32 * u + 4 * fq;
                    const v2u lo = *(const LAS v2u*)vp, hi = *(const LAS v2u*)(vp + 16);
                    o[dt] = __builtin_amdgcn_mfma_f32_16x16x32_bf16(__builtin_bit_cast(bf16x8, (v4u){lo.x, lo.y, hi.x, hi.y}), bp, o[dt], 0, 0, 0); } } }
        bf16* op = MIX + qrow * D + MIX_B + hq * 64 + 4 * fq;
#pragma unroll
        for (int dt = 0; dt < 4; ++dt) { v2u w; w.x = pk2(o[dt].x * inv, o[dt].y * inv); w.y = pk2(o[dt].z * inv, o[dt].w * inv); *(v2u*)(op + 16 * dt) = w; }
    }
    LBAR();
}

struct SeqItem { int row0, nvalid, slot, h; };
__device__ __forceinline__ SeqItem seq_item(int j) {
    SeqItem it;
    if (j < 1024) { it.h = j & 7; const int bc = j >> 3, c = bc & 31, b = bc >> 5; it.row0 = b * TT + c * 64; it.nvalid = 64; it.slot = (b * 8 + it.h) * 32 + c; }
    else { const int js = j - 1024; it.h = js & 7; const int sb = js >> 3; it.row0 = MP + sb * 16; it.nvalid = 16; it.slot = 1024 + js; }
    return it;
}
template <bool ISA> struct RC { static constexpr int DK = ISA ? 128 : 64, NPART = 512 / DK, RPP = 64 / NPART, PK = DK + 8, NQ = ISA ? 2 : 1, NS = ISA ? 4 : 2; };
template <bool ISA> struct MixRegs { v4u q[RC<ISA>::NQ], z[RC<ISA>::NQ]  , v[2], ca; float c0, c1, c2; };
template <bool ISA, bool P3>
__device__ __forceinline__ void mix_load(MixRegs<ISA>& R, const Args& a, int l, int j, int tid) {
    constexpr int DK = RC<ISA>::DK;
    const SeqItem it = seq_item(j); const bf16* PROJ = (const bf16*)(a.ws + WS_PROJ); const v4u z4 = {0u, 0u, 0u, 0u};
    if (ISA) {
#pragma unroll
        for (int jj = 0; jj < 2; ++jj) { const int ci = tid + 512 * jj, row = ci >> 4, c8 = ci & 15; const bool ok = row < it.nvalid; const bf16* p = PROJ + (size_t)(it.row0 + row) * INP + it.h * 128 + 8 * c8;
            if (P3) R.q[jj] = ok ? *(const v4u*)(p + A_Q) : z4;
            R.z[jj] = ok ? *(const v4u*)(p + A_F) : z4; R.v[jj] = ok ? *(const v4u*)(p + A_I) : z4; }
        const float* lba = (const float*)(a.ws + WS_LB); const int ci = l * 1024 + it.h * 128 + (tid & 127);
        R.c0 = lba[ci]; R.c1 = lba[2048 + ci]; R.c2 = lba[4096 + ci];
    } else {
        { const int row = tid >> 3, c8 = tid & 7; const bool ok = row < it.nvalid; const bf16* p = PROJ + (size_t)(it.row0 + row) * INP + it.h * 64 + 8 * c8;
          if (P3) R.q[0] = ok ? *(const v4u*)(p + C_Q) : z4;
          R.z[0] = ok ? *(const v4u*)(p + C_K) : z4; }
#pragma unroll
        for (int jj = 0; jj < 2; ++jj) { const int ci = tid + 512 * jj, row = ci >> 4, c8 = ci & 15; R.v[jj] = row < it.nvalid ? *(const v4u*)(PROJ + (size_t)(it.row0 + row) * INP + C_V + it.h * 128 + 8 * c8) : z4; }
        { const int row = (tid >> 1) & 63, hf = tid & 1; R.ca = row < it.nvalid ? *(const v4u*)((const bf16*)(a.ws + WS_CAB) + (size_t)(it.row0 + row) * 16 + 8 * hf) : z4; }
    }
}
struct GlaW { float w2[16]; float ba; };
__device__ __forceinline__ void gla_w_load(GlaW& W, const Args& a, int l, int h, int tid) {
#pragma unroll
    for (int jj = 0; jj < 16; ++jj) W.w2[jj] = a.in[11][((size_t)l * 16 + jj) * 512 + h * 64 + (tid & 63)];
    W.ba = a.in[12][l * 512 + h * 64 + (tid & 63)];
}
template <bool ISA> struct ML { static constexpr int PK = RC<ISA>::PK, QD = 0, KD = QD + 64 * PK * 2, QE = KD + 64 * PK * 2, ST = QE + 64 * PK * 2, VT = ST + 128 * PK * 2, ATT = VT + 128 * 72 * 2, TOT = ATT + 64 * 72 * 2,
    KT = 0  , RAW = ISA ? ST : TOT + 2048, RQ = RAW, RZ = RQ + 64 * PK * 2, RV = RZ + 64 * PK * 2, RCA = RV + 64 * 136 * 2, END = RCA + 64 * 24 * 2,
    P1_VT = 18432, P1_TOT = 36864, P1_RZ = 38912, P1_RV = P1_RZ + 64 * PK * 2, P1_RCA = P1_RV + 64 * 136 * 2; };
static_assert(ML<true>::RV + 64 * 136 * 2 <= ML<true>::ATT && ML<false>::END <= RING_BYTES && ML<true>::TOT + 2048 <= RING_BYTES, "mixer LDS map");
template <bool ISA, bool P3>
__device__ __forceinline__ void mix_stage(const MixRegs<ISA>& R, const GlaW& W, LAS unsigned char* lds, int tid, float (&zr)[RC<ISA>::RPP], float (&gl)[RC<ISA>::RPP], unsigned (&vw)[8]) {
    constexpr int DK = RC<ISA>::DK, RPP = RC<ISA>::RPP, PK = RC<ISA>::PK;
    LAS bf16* rq = (LAS bf16*)(lds + (P3 ? ML<ISA>::RQ : 0)); LAS bf16* rz = (LAS bf16*)(lds + (P3 ? ML<ISA>::RZ : ML<ISA>::P1_RZ)); LAS bf16* rv = (LAS bf16*)(lds + (P3 ? ML<ISA>::RV : ML<ISA>::P1_RV));
    LAS bf16* rca = (LAS bf16*)(lds + (P3 ? ML<ISA>::RCA : ML<ISA>::P1_RCA));
    if (ISA) {
#pragma unroll
        for (int jj = 0; jj < 2; ++jj) { const int ci = tid + 512 * jj, row = ci >> 4, c8 = ci & 15;
            if (P3) *(LAS v4u*)(rq + row * PK + 8 * c8) = R.q[jj];
            *(LAS v4u*)(rz + row * PK + 8 * c8) = R.z[jj]; *(LAS v4u*)(rv + row * 136 + 8 * c8) = R.v[jj]; }
    } else {
        { const int row = tid >> 3, c8 = tid & 7; if (P3) *(LAS v4u*)(rq + row * PK + 8 * c8) = R.q[0]; *(LAS v4u*)(rz + row * PK + 8 * c8) = R.z[0]; }
#pragma unroll
        for (int jj = 0; jj < 2; ++jj) { const int ci = tid + 512 * jj, row = ci >> 4, c8 = ci & 15; *(LAS v4u*)(rv + row * 136 + 8 * c8) = R.v[jj]; }
        if (tid < 128) *(LAS v4u*)(rca + (tid >> 1) * 24 + 8 * (tid & 1)) = R.ca;
    }
    LBAR();
    const int col = tid & (DK - 1), r0 = (tid / DK) * RPP;
#pragma unroll
    for (int i = 0; i < RPP; ++i) { zr[i] = bf2f(rz[(r0 + i) * PK + col]); gl[i] = 0.f; }
    if (!ISA) {
#pragma unroll
        for (int i = 0; i < RPP; ++i) { const v4u c0 = *(const LAS v4u*)(rca + (r0 + i) * 24), c1 = *(const LAS v4u*)(rca + (r0 + i) * 24 + 8); const unsigned cw[8] = {c0.x, c0.y, c0.z, c0.w, c1.x, c1.y, c1.z, c1.w};
            float g = W.ba;
#pragma unroll
            for (int jj = 0; jj < 8; ++jj) g += bflo(cw[jj]) * W.w2[2 * jj] + bfhi(cw[jj]) * W.w2[2 * jj + 1];
            gl[i] = g; } }
    { const int vc = tid & 127, vp = tid >> 7;
#pragma unroll
      for (int i = 0; i < 8; ++i) vw[i] = (unsigned)rv[(16 * vp + 2 * i) * 136 + vc] | ((unsigned)rv[(16 * vp + 2 * i + 1) * 136 + vc] << 16); }
}
template <bool ISA>
__device__ __forceinline__ void mix_gates(const MixRegs<ISA>& R, int nvalid, LAS float* tot, int tid, const float (&zr)[RC<ISA>::RPP], const float (&gl)[RC<ISA>::RPP], float (&cum)[RC<ISA>::RPP], float (&kk)[RC<ISA>::RPP], float& last, float& cref) {
    constexpr int DK = RC<ISA>::DK, NPART = RC<ISA>::NPART, RPP = RC<ISA>::RPP;
    const int col = tid & (DK - 1), part = tid / DK, r0 = part * RPP; float run = 0.f;
    const float lbf = fmaxf(1.0f - R.c2, 1e-30f);
#pragma unroll
    for (int i = 0; i < RPP; ++i) { float lf = 0.f, kv = 0.f;
        if (r0 + i < nvalid) {
            if (ISA) { const float z = zr[i], e = __expf(-fabsf(z)), t = __builtin_amdgcn_rcpf(1.0f + e);
                const float f = lbf + R.c2 * ((z >= 0.f ? 1.0f : e) * t);
                lf = __logf(f); kv = R.c2 * ((z >= 0.f ? e : 1.0f) * t); }
            else { const float g = gl[i]; lf = (fminf(g, 0.f) - __logf(1.0f + __expf(-fabsf(g)))) * (1.0f / 16.0f); kv = zr[i]; } }
        run += lf; cum[i] = run; kk[i] = kv; }
    tot[part * DK + col] = run;
    LBAR();
    float off = 0.f, tl = 0.f, cr = 0.f;
#pragma unroll
    for (int p = 0; p < NPART; ++p) { const float t = tot[p * DK + col]; if (p < part) off += t; if (p < NPART / 2) cr += t; tl += t; }
#pragma unroll
    for (int i = 0; i < RPP; ++i) cum[i] += off;
    last = tl; cref = cr;
}
template <bool ISA>
__device__ __forceinline__ void pass1_compute(const MixRegs<ISA>& R, const GlaW& W, const Args& a, LAS unsigned char* lds, int j, int tid, int lane, int wave) {
    constexpr int DK = RC<ISA>::DK, RPP = RC<ISA>::RPP;
    const SeqItem it = seq_item(j);
    LAS bf16* kT = (LAS bf16*)lds;
    LAS bf16* vT = (LAS bf16*)(lds + ML<ISA>::P1_VT);
    LAS float* tot = (LAS float*)(lds + ML<ISA>::P1_TOT);
    float zr[RPP], gl[RPP], cum[RPP], kk[RPP], last, cref; unsigned vw[8];
    mix_stage<ISA, false>(R, W, lds, tid, zr, gl, vw);
    mix_gates<ISA>(R, it.nvalid, tot, tid, zr, gl, cum, kk, last, cref);
    const int col = tid & (DK - 1), part = tid / DK, r0 = part * RPP;
    { unsigned w[RPP / 2];
#pragma unroll
      for (int i = 0; i < RPP / 2; ++i) w[i] = pk2(kk[2 * i] * __expf(last - cum[2 * i]), kk[2 * i + 1] * __expf(last - cum[2 * i + 1]));
      LAS v4u* dst = (LAS v4u*)(kT + col * 72 + r0);
#pragma unroll
      for (int i = 0; i < RPP / 8; ++i) dst[i] = (v4u){w[4 * i], w[4 * i + 1], w[4 * i + 2], w[4 * i + 3]}; }
    if (part == 0) ((float*)(a.ws + (ISA ? WS_DA : WS_DC)))[(size_t)it.slot * DK + col] = __expf(last);
    { LAS v4u* dst = (LAS v4u*)(vT + (tid & 127) * 72 + 16 * (tid >> 7)); dst[0] = (v4u){vw[0], vw[1], vw[2], vw[3]}; dst[1] = (v4u){vw[4], vw[5], vw[6], vw[7]}; }
    LBAR();
    const int fr = lane & 15, fq = lane >> 4;
    bf16* U = (bf16*)(a.ws + (ISA ? WS_UA : WS_UC)) + (size_t)it.slot * 128 * DK;
    const LAS bf16* vrow = vT + (16 * wave + fr) * 72 + 8 * fq;
#pragma unroll
    for (int nt = 0; nt < DK / 16; ++nt) { const f32x4 acc = tile_mma<2>((f32x4){0.f, 0.f, 0.f, 0.f}, kT + (16 * nt + fr) * 72 + 8 * fq, vrow);
        *(v2u*)(U + (size_t)(16 * wave + fr) * DK + 16 * nt + 4 * fq) = (v2u){pk2(acc.x, acc.y), pk2(acc.z, acc.w)}; }
    LBAR();
}
template <bool ISA>
__device__ __forceinline__ void pass3_compute(const MixRegs<ISA>& R, const GlaW& W, const Args& a, LAS unsigned char* lds, int l, int j, int tid, int lane, int wave) {
    constexpr int DK = RC<ISA>::DK, RPP = RC<ISA>::RPP, PK = RC<ISA>::PK;
    const SeqItem it = seq_item(j);
    LAS bf16* qd = (LAS bf16*)(lds + ML<ISA>::QD); LAS bf16* kd = (LAS bf16*)(lds + ML<ISA>::KD); LAS bf16* qe = (LAS bf16*)(lds + ML<ISA>::QE); LAS bf16* sT = (LAS bf16*)(lds + ML<ISA>::ST);
    LAS bf16* vT = (LAS bf16*)(lds + ML<ISA>::VT); LAS bf16* att = (LAS bf16*)(lds + ML<ISA>::ATT); LAS float* tot = (LAS float*)(lds + ML<ISA>::TOT);
    LAS float* ofl = (LAS float*)lds;
    float zr[RPP], gl[RPP], cum[RPP], kk[RPP], last, cref; unsigned vw[8];
    mix_stage<ISA, true>(R, W, lds, tid, zr, gl, vw);
    v4u sreg[RC<ISA>::NS];
    { const bf16* S = (const bf16*)(a.ws + (ISA ? WS_STA : WS_STC)) + (size_t)it.slot * 128 * DK;
#pragma unroll
      for (int i = 0; i < RC<ISA>::NS; ++i) sreg[i] = *(const v4u*)(S + (size_t)8 * (tid + 512 * i)); }
    mix_gates<ISA>(R, it.nvalid, tot, tid, zr, gl, cum, kk, last, cref);
    const int col = tid & (DK - 1), part = tid / DK, r0 = part * RPP;
    { const LAS bf16* rq = (const LAS bf16*)(lds + ML<ISA>::RQ);
#pragma unroll
      for (int i = 0; i < RPP; ++i) { const int r = r0 + i; const float q = bf2f(rq[r * PK + col]) * (ISA ? 1.0f : 0.125f);
          const float e1 = __expf(cum[i] - cref);
          qd[r * PK + col] = (bf16)f2bf(q * e1); kd[r * PK + col] = (bf16)f2bf(kk[i] * __builtin_amdgcn_rcpf(e1)); qe[r * PK + col] = (bf16)f2bf(q * __expf(cum[i])); } }
    LBAR();
    { LAS v4u* dst = (LAS v4u*)(vT + (tid & 127) * 72 + 16 * (tid >> 7)); dst[0] = (v4u){vw[0], vw[1], vw[2], vw[3]}; dst[1] = (v4u){vw[4], vw[5], vw[6], vw[7]}; }
#pragma unroll
    for (int i = 0; i < RC<ISA>::NS; ++i) { const int idx = tid + 512 * i, v = idx / (DK / 8), dc = idx % (DK / 8); *(LAS v4u*)(sT + v * PK + 8 * dc) = sreg[i]; }
    v4u greg[2];
    { const int t = tid >> 3, seg = tid & 7; const bool ok = t < it.nvalid; const bf16* gp = (const bf16*)(a.ws + WS_PROJ) + (size_t)(it.row0 + t) * INP + (ISA ? A_G : C_R) + it.h * 128 + 16 * seg;
      const v4u z4 = {0u, 0u, 0u, 0u}; greg[0] = ok ? *(const v4u*)gp : z4; greg[1] = ok ? *(const v4u*)(gp + 8) : z4; }
    LBAR();
    const int fr = lane & 15, fq = lane >> 4;
    { const int mt = wave >> 1;
#pragma unroll
      for (int n2 = 0; n2 < 2; ++n2) { const int nt = 2 * (wave & 1) + n2; f32x4 acc = {0.f, 0.f, 0.f, 0.f};
          if (nt <= mt) { acc = tile_mma<DK / 32>(acc, kd + (16 * nt + fr) * PK + 8 * fq, qd + (16 * mt + fr) * PK + 8 * fq);
              const int t = 16 * mt + fr, s0 = 16 * nt + 4 * fq;
              if (s0 + 0 > t) acc.x = 0.f; if (s0 + 1 > t) acc.y = 0.f; if (s0 + 2 > t) acc.z = 0.f; if (s0 + 3 > t) acc.w = 0.f; }
          *(LAS v2u*)(att + (16 * mt + fr) * 72 + 16 * nt + 4 * fq) = (v2u){pk2(acc.x, acc.y), pk2(acc.z, acc.w)}; } }
    const int mt2 = wave & 3, ntb = 4 * (wave >> 2);
    f32x4 o[4];
#pragma unroll
    for (int jj = 0; jj < 4; ++jj) o[jj] = tile_mma<DK / 32>((f32x4){0.f, 0.f, 0.f, 0.f}, sT + (16 * (ntb + jj) + fr) * PK + 8 * fq, qe + (16 * mt2 + fr) * PK + 8 * fq);
    LBAR();
#pragma unroll
    for (int jj = 0; jj < 4; ++jj) o[jj] = tile_mma<2>(o[jj], vT + (16 * (ntb + jj) + fr) * 72 + 8 * fq, att + (16 * mt2 + fr) * 72 + 8 * fq);
    LBAR();
    f32x4 nw[4];
#pragma unroll
    for (int i = 0; i < 4; ++i) nw[i] = *(const f32x4*)(a.in[ISA ? 9 : 13] + l * 128 + 16 * (tid & 7) + 4 * i);
#pragma unroll
    for (int jj = 0; jj < 4; ++jj) *(LAS f32x4*)(ofl + (16 * mt2 + fr) * 132 + 16 * (ntb + jj) + 4 * fq) = o[jj];
    LBAR();
    { const int t = tid >> 3, seg = tid & 7; f32x4 x[4]; float ss = 0.f;
#pragma unroll
      for (int i = 0; i < 4; ++i) { x[i] = *(const LAS f32x4*)(ofl + t * 132 + 16 * seg + 4 * i); ss += (x[i].x * x[i].x + x[i].y * x[i].y) + (x[i].z * x[i].z + x[i].w * x[i].w); }
      ss += __shfl_xor(ss, 1); ss += __shfl_xor(ss, 2); ss += __shfl_xor(ss, 4);
      const float rstd = 1.0f / sqrtf(ss * (1.0f / 128.0f) + EPS);
      if (t < it.nvalid) { const size_t row = (size_t)(it.row0 + t);
          const unsigned gw[8] = {greg[0].x, greg[0].y, greg[0].z, greg[0].w, greg[1].x, greg[1].y, greg[1].z, greg[1].w}; unsigned ow[8];
#pragma unroll
          for (int i = 0; i < 4; ++i) { const f32x4 n4 = nw[i];
              const float ga = bflo(gw[2 * i]), gb = bfhi(gw[2 * i]), gc = bflo(gw[2 * i + 1]), gd = bfhi(gw[2 * i + 1]);
              ow[2 * i] = pk2(x[i].x * rstd * n4.x * pg8::silu_f(ga), x[i].y * rstd * n4.y * pg8::silu_f(gb));
              ow[2 * i + 1] = pk2(x[i].z * rstd * n4.z * pg8::silu_f(gc), x[i].w * rstd * n4.w * pg8::silu_f(gd)); }
          bf16* op = (bf16*)(a.ws + WS_MIX) + row * D + (ISA ? MIX_A : MIX_C) + it.h * 128 + 16 * seg;
          *(v4u*)op = (v4u){ow[0], ow[1], ow[2], ow[3]}; *(v4u*)(op + 8) = (v4u){ow[4], ow[5], ow[6], ow[7]}; } }
    LBAR();
}
#define MIX_W(j) do { if (!ISA && !hoist) gla_w_load(W, a, l, seq_item(j).h, tid); } while (0)
template <bool ISA>
__device__ __forceinline__ void pass1_loop(const Args& a, LAS unsigned char* lds, int l, int first, int stride, int tid, int lane, int wave) {
    if (first >= NSLOT) return;
    GlaW W; const bool hoist = (stride & 7) == 0; if (!ISA && hoist) gla_w_load(W, a, l, first & 7, tid);
    MixRegs<ISA> ra, rb; mix_load<ISA, false>(ra, a, l, first, tid);
    for (int j = first;;) {
        if (j + stride < NSLOT) mix_load<ISA, false>(rb, a, l, j + stride, tid);
        MIX_W(j); pass1_compute<ISA>(ra, W, a, lds, j, tid, lane, wave); j += stride; if (j >= NSLOT) break;
        if (j + stride < NSLOT) mix_load<ISA, false>(ra, a, l, j + stride, tid);
        MIX_W(j); pass1_compute<ISA>(rb, W, a, lds, j, tid, lane, wave); j += stride; if (j >= NSLOT) break; }
}
template <bool ISA>
__device__ __forceinline__ void pass3_loop(const Args& a, LAS unsigned char* lds, int l, int first, int stride, int tid, int lane, int wave) {
    if (first >= NSLOT) return;
    GlaW W; const bool hoist = (stride & 7) == 0; if (!ISA && hoist) gla_w_load(W, a, l, first & 7, tid);
    MixRegs<ISA> ra, rb; mix_load<ISA, true>(ra, a, l, first, tid);
    for (int j = first;;) {
        if (j + stride < NSLOT) mix_load<ISA, true>(rb, a, l, j + stride, tid);
        MIX_W(j); pass3_compute<ISA>(ra, W, a, lds, l, j, tid, lane, wave); j += stride; if (j >= NSLOT) break;
        if (j + stride < NSLOT) mix_load<ISA, true>(ra, a, l, j + stride, tid);
        MIX_W(j); pass3_compute<ISA>(rb, W, a, lds, l, j, tid, lane, wave); j += stride; if (j >= NSLOT) break; }
}
template <bool ISA>
__device__ __forceinline__ void scan_vec(const Args& a, int l, int idx) {
    constexpr int DK = RC<ISA>::DK, VPS = 128 * DK / 4;
    const int seq = idx / VPS, e = idx - seq * VPS, v = e / (DK / 4), d4 = (e - v * (DK / 4)) * 4;
    const bf16* __restrict__ U = (const bf16*)(a.ws + (ISA ? WS_UA : WS_UC)); const float* __restrict__ Dv = (const float*)(a.ws + (ISA ? WS_DA : WS_DC));
    bf16* __restrict__ ST = (bf16*)(a.ws + (ISA ? WS_STA : WS_STC));
    if (seq < 32) {
        f32x4 S = {0.f, 0.f, 0.f, 0.f};
#pragma unroll 1
        for (int c0 = 0; c0 < 32; c0 += 8) { f32x4 u[8], dd[8];
#pragma unroll
            for (int j = 0; j < 8; ++j) { const size_t slot = (size_t)seq * 32 + c0 + j; { const v2u uw = *(const v2u*)(U + (slot * 128 + v) * DK + d4); u[j] = (f32x4){bflo(uw.x), bfhi(uw.x), bflo(uw.y), bfhi(uw.y)}; } dd[j] = *(const f32x4*)(Dv + slot * DK + d4); }
#pragma unroll
            for (int j = 0; j < 8; ++j) { const size_t slot = (size_t)seq * 32 + c0 + j; *(v2u*)(ST + (slot * 128 + v) * DK + d4) = (v2u){pk2(S.x, S.y), pk2(S.z, S.w)}; S = dd[j] * S + u[j]; } }
        float* o = a.out + (ISA ? O_SAP : O_SCP) + (((size_t)l * NB * 8 + seq) * DK + d4) * 128 + v;
        o[0] = S.x; o[128] = S.y; o[256] = S.z; o[384] = S.w;
    } else {
        const int ss = seq - 32; const size_t slot = 1024 + ss;
        const float* s0 = a.in[ISA ? 4 : 5] + (((size_t)l * SB * 8 + ss) * DK + d4) * 128 + v;
        const f32x4 S = {s0[0], s0[128], s0[256], s0[384]};
        const v2u uw = *(const v2u*)(U + (slot * 128 + v) * DK + d4); const f32x4 u = {bflo(uw.x), bfhi(uw.x), bflo(uw.y), bfhi(uw.y)}, dd = *(const f32x4*)(Dv + slot * DK + d4);
        *(v2u*)(ST + (slot * 128 + v) * DK + d4) = (v2u){pk2(S.x, S.y), pk2(S.z, S.w)}; const f32x4 F = dd * S + u;
        float* o = a.out + (ISA ? O_SAS : O_SCS) + (((size_t)l * SB * 8 + ss) * DK + d4) * 128 + v;
        o[0] = F.x; o[128] = F.y; o[256] = F.z; o[384] = F.w;
    }
}

template <bool FINAL>
__device__ __forceinline__ void sample_rows_finish(unsigned char* ws, LAS unsigned char* lds, float* ssout, const float* g, float* fout, int tid, int lane, int wave, int bid, int G) {
    LAS float* red = (LAS float*)lds;
    for (int r = bid; r < MS; r += G) { const size_t row = (size_t)MP + r; float s = 0.f; f32x4 x[2];
#pragma unroll
        for (int sg = 0; sg < 2; ++sg) { const int col = (2 * wave + sg) * 256 + 4 * lane; const v2u xb = *(const v2u*)((const bf16*)(ws + WS_XN) + row * D + col);
            x[sg] = (f32x4){bflo(xb.x), bfhi(xb.x), bflo(xb.y), bfhi(xb.y)};
            const float* pp = (const float*)(ws + WS_PART) + (size_t)r * D + col;
#pragma unroll
            for (int ch = 0; ch < 16; ++ch) x[sg] = x[sg] + *(const f32x4*)(pp + (size_t)ch * MS * D);
            s += (x[sg].x * x[sg].x + x[sg].y * x[sg].y) + (x[sg].z * x[sg].z + x[sg].w * x[sg].w); }
        s = wave_sum(s); if (lane == 0) red[wave] = s;
        __syncthreads();
        float t = 0.f;
#pragma unroll
        for (int i = 0; i < NWAVES; ++i) t += red[i];
#pragma unroll
        for (int sg = 0; sg < 2; ++sg) { const int col = (2 * wave + sg) * 256 + 4 * lane;
            if (!FINAL) { v2u w; w.x = pk2(x[sg].x, x[sg].y); w.y = pk2(x[sg].z, x[sg].w); *(v2u*)((bf16*)(ws + WS_XN) + row * D + col) = w; }
            else { const float rstd = 1.0f / sqrtf(t * (1.0f / D) + EPS); *(f32x4*)(fout + row * D + col) = x[sg] * rstd * *(const f32x4*)(g + col); } }
        if (!FINAL && tid == 0) ssout[row] = t;
        __syncthreads(); }
}

__device__ __forceinline__ void ca_item(unsigned char* ws, LAS unsigned char* lds, int l, int rb, int tid, int lane, int wave) {
    const int fr = lane & 15, fq = lane >> 4, row0 = rb * 64;
    const bf16* ap = (const bf16*)(ws + WS_XN) + (size_t)(row0 + fr) * D + wave * 512 + 8 * fq;
    const bf16* bp = (const bf16*)(ws + WS_W1) + (size_t)l * INP * D + ((size_t)(C_A / 128) * (D / 64) + wave * 8) * 8192 + fr * 64 + 8 * fq;
    f32x4 acc[4];
#pragma unroll
    for (int mt = 0; mt < 4; ++mt) acc[mt] = (f32x4){0.f, 0.f, 0.f, 0.f};
#pragma unroll 1
    for (int k0 = 0; k0 < 512; k0 += 128) { bf16x8 av[4][4], bv[4];
#pragma unroll
        for (int ks = 0; ks < 4; ++ks) { bv[ks] = *(const bf16x8*)(bp + (size_t)((k0 + 32 * ks) >> 6) * 8192 + ((k0 + 32 * ks) & 63));
#pragma unroll
            for (int mt = 0; mt < 4; ++mt) av[mt][ks] = *(const bf16x8*)(ap + (size_t)(16 * mt) * D + k0 + 32 * ks); }
#pragma unroll
        for (int ks = 0; ks < 4; ++ks)
#pragma unroll
            for (int mt = 0; mt < 4; ++mt) acc[mt] = __builtin_amdgcn_mfma_f32_16x16x32_bf16(av[mt][ks], bv[ks], acc[mt], 0, 0, 0); }
    LAS f32x4* red = (LAS f32x4*)lds;
#pragma unroll
    for (int mt = 0; mt < 4; ++mt) red[(wave * 4 + mt) * 64 + lane] = acc[mt];
    LBAR();
    if (tid < 256) { const int mt = tid >> 6; f32x4 s = red[mt * 64 + lane];
#pragma unroll
        for (int w = 1; w < 8; ++w) s = s + red[(w * 4 + mt) * 64 + lane];
        const float* ss = (const float*)(ws + WS_SSA);
#pragma unroll
        for (int r = 0; r < 4; ++r) { const int row = row0 + 16 * mt + 4 * fq + r; ((bf16*)(ws + WS_CAB))[(size_t)row * 16 + fr] = (bf16)f2bf(s[r] * pg8::rstd_of(ss[row])); } }
    LBAR();
}

constexpr int PH_PER_LAYER = 10, NPHASE = 1 + PH_PER_LAYER * DEPTH;
__global__ void __launch_bounds__(NWAVES * 64, 2) hymba_fwd(Args a) {
    extern __shared__ __attribute__((aligned(16))) unsigned char lds_raw[];
    LAS unsigned char* lds = (LAS unsigned char*)lds_raw;
    const int G = gridDim.x, bid = blockIdx.x;
    unsigned char* const ws0 = a.ws;
    for (int u = threadIdx.x; u < (LDS_BYTES - RING_BYTES) / 4; u += NWAVES * 64) ((LAS unsigned*)(lds + RING_BYTES))[u] = 0u;
    __syncthreads();
    const int lo = a.ph_lo, hi = a.ph_hi;
    const bool use_vc = (lo == 0 && hi - lo > 1 && (G & 7) == 0);
    if (use_vc && threadIdx.x == 0) { const unsigned x = xb_xcc_id() & 7u; const unsigned r = xb_add((unsigned*)(ws0 + WS_CTL) + CW_RANK + 64 * x, 1u);
        if (r >= (unsigned)(G / 8)) (void)xb_add((unsigned*)(ws0 + WS_CTL) + CW_FALL, 1u);
        ((volatile LAS unsigned*)(lds + MISC_OFF))[16] = r * 8u + x; }
    XcdBarrier bar; bar.bar = (unsigned*)(ws0 + WS_CTL) + CW_BAR; bar.x = 0; bar.st = nullptr;
    if (hi - lo > 1) bar = xcd_barrier_post((unsigned*)(ws0 + WS_CTL) + CW_BAR, (volatile LAS unsigned*)(lds + MISC_OFF) + 8);
#define IN(k) (lo <= (k) && (k) < hi)
#define WSL() GAS unsigned char* ws_g = (GAS unsigned char*)ws0; asm volatile("" : "+s"(ws_g)); unsigned char* ws = (unsigned char*)ws_g
#define LAUNDER() WSL(); (void)ws; int tid = threadIdx.x; asm volatile("" : "+v"(tid)); const int lane = tid & 63, wave = __builtin_amdgcn_readfirstlane(tid >> 6); (void)lane; (void)wave
#define SEAM(k) do { if ((k) + 1 < hi) xcd_barrier(bar); } while (0)

    if (IN(0)) { LAUNDER(); prologue(a, lds, tid, lane, wave, bid, G); SEAM(0); }
    int vc = bid;
    if (use_vc) { const unsigned fall = xb_ld((unsigned*)(ws0 + WS_CTL) + CW_FALL); const unsigned v = ((volatile LAS unsigned*)(lds + MISC_OFF))[16]; if (fall == 0u && v < (unsigned)G) vc = (int)v; }
    vc = __builtin_amdgcn_readfirstlane(vc);

#pragma unroll 1
    for (int l = 0; l < DEPTH; ++l) {
        const int pb = 1 + PH_PER_LAYER * l;
        if (IN(pb + 0)) { WSL();
            constexpr int NG1 = C_A;
            pg8::Gemm g{(const pg8::bf16_t*)(ws + WS_XN), (const pg8::bf16_t*)(ws + WS_W1) + (size_t)l * INP * D, MP, NG1, D};
            { pg8::StaticOrder S; S.init(MP, NG1, D, G, vc); S.WGM = 8; pg8::EpiProj<2> E{(pg8::bf16_t*)(ws + WS_PROJ), INP, (const float*)(ws + WS_SSA)};
              pg8::gemm_phase<pg8::EpiProj<2>, pg8::StaticOrder, true, true, false>(lds, g, S, E); }
            const int rem = ((MP / 256) * (NG1 / 256)) % G, nfree = G - rem, fidx = vc >= rem ? vc - rem : -1;
            { pg8::PanelOrder S{MP / 256, NG1 / 256, 1, D / 64, fidx, nfree, NG1 / 256}; pg8::EpiProj<1> E{(pg8::bf16_t*)(ws + WS_PROJ), INP, (const float*)(ws + WS_SSA)};
              pg8::gemm_phase<pg8::EpiProj<1>, pg8::PanelOrder, true, true, true>(lds, g, S, E); }
            { int tid = threadIdx.x; asm volatile("" : "+v"(tid)); const int lane = tid & 63, wave = __builtin_amdgcn_readfirstlane(tid >> 6);
              const int nsamp = NG1 / 256, ncaw = nfree > nsamp ? nfree - nsamp : nfree, cfirst = nfree > nsamp ? fidx - nsamp : fidx;
              if (fidx >= 0 && cfirst >= 0) for (int rb = cfirst; rb < MV / 64; rb += ncaw) ca_item(ws, lds, l, rb, tid, lane, wave); }
            SEAM(pb + 0);
        }
        if (IN(pb + 1)) { LAUNDER();
            constexpr int NSWA = 512 + 32;
            for (int it = bid; it < 512; it += G) swa_prompt_item(a, lds, l, it, tid, lane, wave);
            for (int it = 512 + ((bid + G - 64) % G); it < NSWA; it += G) swa_item(a, lds, l, it, tid, lane, wave);
            pass1_loop<true>(a, lds, l, bid, G, tid, lane, wave);
            pass1_loop<false>(a, lds, l, (G & 7) == 0 && G >= 256 ? (bid + G - 128) % G : bid, G, tid, lane, wave);
            SEAM(pb + 1);
        }
        if (IN(pb + 2)) { LAUNDER();
            const int gt = bid * 512 + tid, NT = G * 512;
            constexpr int NA = 96 * 128 * 128 / 4, NC = 96 * 128 * 64 / 4;
            for (int i = gt; i < NA; i += NT) scan_vec<true>(a, l, i);
            for (int i = gt; i < NC; i += NT) scan_vec<false>(a, l, i);
            SEAM(pb + 2);
        }
        if (IN(pb + 3)) { LAUNDER();
            pass3_loop<true>(a, lds, l, bid, G, tid, lane, wave);
            pass3_loop<false>(a, lds, l, (G & 7) == 0 && G >= 256 ? (bid + G - 128) % G : bid, G, tid, lane, wave);
            SEAM(pb + 3);
        }
        if (IN(pb + 4)) { WSL();
            pg8::Gemm g{(const pg8::bf16_t*)(ws + WS_MIX), (const pg8::bf16_t*)(ws + WS_W2) + (size_t)l * D * D, MP, D, D};
            { pg8::StaticOrder S; S.init(MP, D, D, G, vc); pg8::EpiResidN E{(pg8::bf16_t*)(ws + WS_XN), (float*)(ws + WS_SSP), D};
              pg8::gemm_phase<pg8::EpiResidN, pg8::StaticOrder, true, true, false>(lds, g, S, E); }
            { pg8::PanelOrder S{MP / 256, D / 256, 16, D / 64, bid, G, 16 * (D / 256)}; pg8::EpiPartial E{(float*)(ws + WS_PART), D};
              pg8::gemm_phase<pg8::EpiPartial, pg8::PanelOrder, true, true, true>(lds, g, S, E); }
            SEAM(pb + 4);
        }
        if (IN(pb + 5)) { LAUNDER();
            const int gw = bid * NWAVES + wave, NGW = G * NWAVES;
            for (int i = bid * 512 + tid; i < MP * 16; i += G * 512) { const int row = i >> 4, q = i & 15; const f32x4 pv = *(const f32x4*)((const float*)(ws + WS_SSP) + (size_t)row * 64 + 4 * q);
                float s = (pv.x + pv.y) + (pv.z + pv.w); s += __shfl_xor(s, 1); s += __shfl_xor(s, 2); s += __shfl_xor(s, 4); s += __shfl_xor(s, 8); if (q == 0) ((float*)(ws + WS_SSB))[row] = s; }
            sample_rows_finish<false>(ws, lds, (float*)(ws + WS_SSB), nullptr, nullptr, tid, lane, wave, bid, G);
            SEAM(pb + 5);
        }
        if (IN(pb + 6)) { WSL();
            pg8::Gemm g{(const pg8::bf16_t*)(ws + WS_XN), (const pg8::bf16_t*)(ws + WS_W3) + (size_t)l * 2 * DFF * D, MP, 2 * DFF, D};
            { pg8::StaticOrder S; S.init(MP, 2 * DFF, D, G, vc); S.WGM = 4; pg8::EpiSwiGLU<2> E{(pg8::bf16_t*)(ws + WS_ACT), DFF, (const float*)(ws + WS_SSB)};
              pg8::gemm_phase<pg8::EpiSwiGLU<2>, pg8::StaticOrder, true, true, false>(lds, g, S, E); }
            { const int rem = ((MP / 256) * (2 * DFF / 256)) % G; pg8::TriOrder S{MP / 256, 2 * DFF / 128, D / 64, vc >= rem ? vc - rem : -1, G - rem};
              pg8::EpiGU E{(float*)(ws + WS_GU), 2 * DFF, (const float*)(ws + WS_SSB) + MP};
              pg8::gemm_phase<pg8::EpiGU, pg8::TriOrder, true, true, 2>(lds, g, S, E); }
            SEAM(pb + 6);
        }
        if (IN(pb + 7)) { LAUNDER();
            const float* GU = (const float*)(ws + WS_GU); bf16* ACT = (bf16*)(ws + WS_ACT) + (size_t)MP * DFF;
            for (int idx = bid * 512 + tid; idx < MS * (DFF / 4); idx += G * 512) { const int r = idx / (DFF / 4), j4 = (idx - r * (DFF / 4)) * 4, t = j4 >> 7, i = j4 & 127;
                const f32x4 gg = *(const f32x4*)(GU + (size_t)r * 2 * DFF + 256 * t + i), uu = *(const f32x4*)(GU + (size_t)r * 2 * DFF + 256 * t + 128 + i);
                *(v2u*)(ACT + (size_t)r * DFF + j4) = (v2u){pk2(pg8::silu_f(gg.x) * uu.x, pg8::silu_f(gg.y) * uu.y), pk2(pg8::silu_f(gg.z) * uu.z, pg8::silu_f(gg.w) * uu.w)}; }
            SEAM(pb + 7);
        }
        if (IN(pb + 8)) { WSL();
            pg8::Gemm g{(const pg8::bf16_t*)(ws + WS_ACT), (const pg8::bf16_t*)(ws + WS_W4) + (size_t)l * D * DFF, MP, D, DFF};
            { pg8::StaticOrder S; S.init(MP, D, DFF, G, vc); pg8::EpiResidN E{(pg8::bf16_t*)(ws + WS_XN), (float*)(ws + WS_SSP), D};
              pg8::gemm_phase<pg8::EpiResidN, pg8::StaticOrder, true, true, false>(lds, g, S, E); }
            { pg8::PanelOrder S{MP / 256, D / 256, 16, DFF / 64, bid, G, 16 * (D / 256)}; pg8::EpiPartial E{(float*)(ws + WS_PART), D};
              pg8::gemm_phase<pg8::EpiPartial, pg8::PanelOrder, true, true, true>(lds, g, S, E); }
            SEAM(pb + 8);
        }
        if (IN(pb + 9)) { LAUNDER();
            const int gw = bid * NWAVES + wave, NGW = G * NWAVES;
            if (l + 1 < DEPTH) {
                for (int i = bid * 512 + tid; i < MP * 16; i += G * 512) { const int row = i >> 4, q = i & 15; const f32x4 pv = *(const f32x4*)((const float*)(ws + WS_SSP) + (size_t)row * 64 + 4 * q);
                float s = (pv.x + pv.y) + (pv.z + pv.w); s += __shfl_xor(s, 1); s += __shfl_xor(s, 2); s += __shfl_xor(s, 4); s += __shfl_xor(s, 8); if (q == 0) ((float*)(ws + WS_SSA))[row] = s; }
                sample_rows_finish<false>(ws, lds, (float*)(ws + WS_SSA), nullptr, nullptr, tid, lane, wave, bid, G);
            } else { sample_rows_finish<true>(ws, lds, nullptr, a.in[18], a.out + O_YP, tid, lane, wave, bid, G); for (int m = gw; m < MP; m += 2 * NGW) final_rows2((const bf16*)(ws + WS_XN), a.in[18], a.out + O_YP, m, m + NGW < MP ? m + NGW : m, lane); }
            SEAM(pb + 9);
        }
    }
#undef IN
#undef SEAM
}

#ifndef MK_PER_PHASE
#define MK_PER_PHASE 0
#endif
extern "C" void kernel_launch(void* const* d_in, const int* in_sizes, int n_in, void* d_out, int out_size, void* d_ws, size_t ws_size, hipStream_t stream) {
    static int grid = 0;
    if (grid == 0) {
        if (n_in != 19 || (size_t)out_size != O_END || ws_size < WS_END) { fprintf(stderr, "kernel_launch: unexpected shapes (n_in %d, out %d, ws %zu need %zu)\n", n_in, out_size, ws_size, (size_t)WS_END); grid = -1; return; }
        int dev = 0, cus = 0, per_cu = 0;
        if (hipGetDevice(&dev) != hipSuccess || hipDeviceGetAttribute(&cus, hipDeviceAttributeMultiprocessorCount, dev) != hipSuccess) { grid = -1; return; }
        if (hipFuncSetAttribute((const void*)hymba_fwd, hipFuncAttributeMaxDynamicSharedMemorySize, LDS_BYTES) != hipSuccess) { fprintf(stderr, "kernel_launch: hipFuncSetAttribute failed\n"); grid = -1; return; }
        if (hipOccupancyMaxActiveBlocksPerMultiprocessor(&per_cu, (const void*)hymba_fwd, NWAVES * 64, LDS_BYTES) != hipSuccess || per_cu < 1) { fprintf(stderr, "kernel_launch: occupancy query says %d\n", per_cu); }
        (void)hipGetLastError();
        grid = cus;
    }
    if (grid < 0) return;
    (void)hipMemsetAsync((char*)d_ws + WS_CTL, 0, CTL_BYTES, stream);
    Args a{};
    for (int i = 0; i < 19; ++i) a.in[i] = (const float*)d_in[i];
    a.out = (float*)d_out; a.ws = (unsigned char*)d_ws;
#if MK_PER_PHASE
    for (int p = 0; p < NPHASE; ++p) { a.ph_lo = p; a.ph_hi = p + 1; hipLaunchKernelGGL(hymba_fwd, dim3(grid), dim3(NWAVES * 64), LDS_BYTES, stream, a); }
#else
    a.ph_lo = 0; a.ph_hi = NPHASE; hipLaunchKernelGGL(hymba_fwd, dim3(grid), dim3(NWAVES * 64), LDS_BYTES, stream, a);
#endif
}
```
